# Optimizing an MI355X kernel written in HIP

```python
import math
import jax, jax.numpy as jnp
from jax import lax
import numpy as np

D_MODEL = 1024
BATCH = 16
SEQ = 2048
DEPTH = 2

S5_WIDTH = 512
S5_GROUP = 16
S5_GROUPS = S5_WIDTH // S5_GROUP
S5_STATE = 64
SGU_WIDTH = 512
SGU_HEADS = 4
SGU_HEAD_DIM = SGU_WIDTH // SGU_HEADS
SGU_CHUNK = 128
N_GROUPS = 4
EXPERTS_PER_GROUP = 8
N_EXPERTS = N_GROUPS * EXPERTS_PER_GROUP
TOP_K = 2
D_EXPERT = 512
MOE_BLOCK = 128
PLE_DIM = 256
IN_COLS = S5_WIDTH + 2 * SGU_WIDTH + 2 * D_MODEL
EPS = 1e-6

kernel_name = "hybrid_s5_sgu_hiermoe_ple"


def rms_norm(x, g):
    xf = x.astype(jnp.float32)
    y = xf * lax.rsqrt(jnp.mean(xf * xf, axis=-1, keepdims=True) + EPS)
    return (y * g.astype(jnp.float32)).astype(x.dtype)


def _complex_combine(c1, c2):
    a1r, a1i, b1r, b1i = c1
    a2r, a2i, b2r, b2i = c2
    ar = a1r * a2r - a1i * a2i
    ai = a1r * a2i + a1i * a2r
    a2rb, a2ib = a2r[:, None], a2i[:, None]
    br = a2rb * b1r - a2ib * b1i + b2r
    bi = a2rb * b1i + a2ib * b1r + b2i
    return (ar, ai, br, bi)


def s5_branch(u, a_re, a_im, log_dt, b_re, b_im, c_re, c_im, d_skip, w_glu):
    bsz, seq, _ = u.shape
    f32 = jnp.float32
    uf = u.astype(f32)
    ug = uf.reshape(bsz, seq, S5_GROUPS, S5_GROUP)
    a_re, a_im = a_re.astype(f32), a_im.astype(f32)
    b_re, b_im = b_re.astype(f32), b_im.astype(f32)
    c_re, c_im = c_re.astype(f32), c_im.astype(f32)
    dt = jnp.exp(log_dt.astype(f32))[:, None]
    mag = jnp.exp(a_re * dt)
    ang = a_im * dt
    lb_re, lb_im = mag * jnp.cos(ang), mag * jnp.sin(ang)
    den = a_re * a_re + a_im * a_im
    nr = lb_re - 1.0
    coef_re = (nr * a_re + lb_im * a_im) / den
    coef_im = (lb_im * a_re - nr * a_im) / den
    bb_re = coef_re[..., None] * b_re - coef_im[..., None] * b_im
    bb_im = coef_re[..., None] * b_im + coef_im[..., None] * b_re
    bu_re = jnp.einsum('blgc,gnc->lbgn', ug, bb_re)
    bu_im = jnp.einsum('blgc,gnc->lbgn', ug, bb_im)
    lam_re = jnp.broadcast_to(lb_re, (seq,) + lb_re.shape)
    lam_im = jnp.broadcast_to(lb_im, (seq,) + lb_im.shape)
    _, _, h_re, h_im = lax.associative_scan(_complex_combine, (lam_re, lam_im, bu_re, bu_im), axis=0)
    y = jnp.einsum('lbgn,gcn->blgc', h_re, c_re) - jnp.einsum('lbgn,gcn->blgc', h_im, c_im)
    y = y.reshape(bsz, seq, S5_WIDTH) + d_skip.astype(f32) * uf
    y = jax.nn.gelu(y).astype(u.dtype)
    z = y @ w_glu
    return z[..., :D_MODEL] * jax.nn.sigmoid(z[..., D_MODEL:])


def sgu_branch(u, v, norm_w, w_s, b_s, w_proj):
    bsz, seq, _ = v.shape
    u = jax.nn.gelu(u)
    v = jax.nn.gelu(v)
    vh = rms_norm(v.reshape(bsz, seq, SGU_HEADS, SGU_HEAD_DIM), norm_w.reshape(SGU_HEADS, SGU_HEAD_DIM))
    vc = vh.reshape(bsz, seq // SGU_CHUNK, SGU_CHUNK, SGU_HEADS, SGU_HEAD_DIM)
    mask = jnp.tril(jnp.ones((SGU_CHUNK, SGU_CHUNK), dtype=bool))
    ws = jnp.where(mask[None], w_s, jnp.zeros_like(w_s))
    s = jnp.einsum('hts,bcshd->bcthd', ws, vc) + b_s.T[None, None, :, :, None]
    s = s.reshape(bsz, seq, SGU_WIDTH)
    return (u * s) @ w_proj


def hier_moe(xn, w_rg, b_rg, w_re, b_re, w_gate, w_up, w_down):
    bsz, seq, d = xn.shape
    n_tok = bsz * seq
    xt = xn.reshape(n_tok, d)
    gl = (xt @ w_rg + b_rg).astype(jnp.float32)
    gp = jax.nn.softmax(gl, axis=-1)
    g = jnp.argmax(gl, axis=-1)
    g_w = jnp.take_along_axis(gp, g[:, None], axis=1)[:, 0]
    el = (xt @ w_re + b_re).astype(jnp.float32).reshape(n_tok, N_GROUPS, EXPERTS_PER_GROUP)
    el_g = jnp.take_along_axis(el, g[:, None, None], axis=1)[:, 0]
    top_v, top_i = lax.top_k(el_g, TOP_K)
    w = jax.nn.softmax(top_v, axis=-1) * g_w[:, None]
    eid = (g[:, None] * EXPERTS_PER_GROUP + top_i).reshape(-1).astype(jnp.int32)
    wts = w.reshape(-1)
    tok = jnp.repeat(jnp.arange(n_tok, dtype=jnp.int32), TOP_K)
    n_assign = n_tok * TOP_K
    counts = jax.ops.segment_sum(jnp.ones((n_assign,), jnp.int32), eid, num_segments=N_EXPERTS)
    padded = ((counts + MOE_BLOCK - 1) // MOE_BLOCK) * MOE_BLOCK
    pad_end = jnp.cumsum(padded)
    pad_start = pad_end - padded
    raw_start = jnp.cumsum(counts) - counts
    order = jnp.argsort(eid)
    se = eid[order]
    dest = pad_start[se] + jnp.arange(n_assign, dtype=jnp.int32) - raw_start[se]
    n_rows = (-(-n_assign // MOE_BLOCK)) * MOE_BLOCK + N_EXPERTS * MOE_BLOCK
    n_blocks = n_rows // MOE_BLOCK
    row_tok = jnp.zeros((n_rows,), jnp.int32).at[dest].set(tok[order])
    row_w = jnp.zeros((n_rows,), wts.dtype).at[dest].set(wts[order])
    blk_e = jnp.minimum(jnp.searchsorted(pad_end, jnp.arange(n_blocks, dtype=jnp.int32) * MOE_BLOCK, side='right'),
                        N_EXPERTS - 1).astype(jnp.int32)
    xr = xt[row_tok].reshape(n_blocks, MOE_BLOCK, d)

    def expert_block(args):
        xb, e = args
        hid = jax.nn.silu(xb @ w_gate[e]) * (xb @ w_up[e])
        return hid @ w_down[e]

    yr = lax.map(expert_block, (xr, blk_e)).reshape(n_rows, d)
    y = jax.ops.segment_sum(yr * row_w[:, None].astype(yr.dtype), row_tok, num_segments=n_tok)
    return y.reshape(bsz, seq, d)


def setup_inputs(seed: int = 0) -> dict:
    key = jax.random.key(seed)
    ks = jax.random.split(key, 32)
    f32 = jnp.float32
    nrm = lambda k, shape, s: jax.random.normal(k, shape, f32) * s
    L = DEPTH
    n_idx = jnp.arange(S5_STATE, dtype=f32)
    inp = {}
    inp["x"] = nrm(ks[0], (BATCH, SEQ, D_MODEL), 1.0)
    inp["p"] = nrm(ks[1], (DEPTH, BATCH, SEQ, PLE_DIM), 1.0)
    inp["norm_mix"] = 1.0 + nrm(ks[2], (L, D_MODEL), 0.05)
    inp["w_in"] = nrm(ks[3], (L, D_MODEL, IN_COLS), D_MODEL ** -0.5)
    inp["s5_a_re"] = -0.5 + nrm(ks[4], (L, S5_GROUPS, S5_STATE), 0.01)
    inp["s5_a_im"] = math.pi * n_idx[None, None, :] + nrm(ks[5], (L, S5_GROUPS, S5_STATE), 0.01)
    inp["s5_log_dt"] = jax.random.uniform(ks[6], (L, S5_GROUPS), f32, math.log(1e-3), math.log(1e-1))
    inp["s5_b_re"] = nrm(ks[7], (L, S5_GROUPS, S5_STATE, S5_GROUP), (2 * S5_GROUP) ** -0.5)
    inp["s5_b_im"] = nrm(ks[8], (L, S5_GROUPS, S5_STATE, S5_GROUP), (2 * S5_GROUP) ** -0.5)
    inp["s5_c_re"] = nrm(ks[9], (L, S5_GROUPS, S5_GROUP, S5_STATE), (2 * S5_STATE) ** -0.5 * 4.0)
    inp["s5_c_im"] = nrm(ks[10], (L, S5_GROUPS, S5_GROUP, S5_STATE), (2 * S5_STATE) ** -0.5 * 4.0)
    inp["s5_d"] = nrm(ks[11], (L, S5_WIDTH), 1.0)
    inp["w_glu"] = nrm(ks[12], (L, S5_WIDTH, 2 * D_MODEL), S5_WIDTH ** -0.5)
    inp["sgu_norm"] = 1.0 + nrm(ks[13], (L, SGU_WIDTH), 0.05)
    inp["sgu_w"] = nrm(ks[14], (L, SGU_HEADS, SGU_CHUNK, SGU_CHUNK), SGU_CHUNK ** -0.5)
    inp["sgu_b"] = 1.0 + nrm(ks[15], (L, SGU_HEADS, SGU_CHUNK), 0.1)
    inp["w_sgu_proj"] = nrm(ks[16], (L, SGU_WIDTH, D_MODEL), SGU_WIDTH ** -0.5)
    inp["w_out"] = nrm(ks[17], (L, D_MODEL, D_MODEL), D_MODEL ** -0.5)
    inp["norm_ffn"] = 1.0 + nrm(ks[18], (L, D_MODEL), 0.05)
    inp["w_router_group"] = nrm(ks[19], (L, D_MODEL, N_GROUPS), D_MODEL ** -0.5)
    inp["b_router_group"] = nrm(ks[20], (L, N_GROUPS), 0.01)
    inp["w_router_expert"] = nrm(ks[21], (L, D_MODEL, N_EXPERTS), D_MODEL ** -0.5)
    inp["b_router_expert"] = nrm(ks[22], (L, N_EXPERTS), 0.01)
    inp["w_expert_gate"] = nrm(ks[23], (L, N_EXPERTS, D_MODEL, D_EXPERT), D_MODEL ** -0.5)
    inp["w_expert_up"] = nrm(ks[24], (L, N_EXPERTS, D_MODEL, D_EXPERT), D_MODEL ** -0.5)
    inp["w_expert_down"] = nrm(ks[25], (L, N_EXPERTS, D_EXPERT, D_MODEL), D_EXPERT ** -0.5)
    inp["norm_ple"] = 1.0 + nrm(ks[26], (L, D_MODEL), 0.05)
    inp["w_ple_gate"] = nrm(ks[27], (L, D_MODEL, D_MODEL), D_MODEL ** -0.5)
    inp["w_ple_proj"] = nrm(ks[28], (L, PLE_DIM, D_MODEL), PLE_DIM ** -0.5)
    inp["norm_final"] = 1.0 + nrm(ks[29], (D_MODEL,), 0.05)
    return inp


def reference(x, p, norm_mix, w_in, s5_a_re, s5_a_im, s5_log_dt, s5_b_re, s5_b_im, s5_c_re, s5_c_im,
              s5_d, w_glu, sgu_norm, sgu_w, sgu_b, w_sgu_proj, w_out, norm_ffn, w_router_group,
              b_router_group, w_router_expert, b_router_expert, w_expert_gate, w_expert_up,
              w_expert_down, norm_ple, w_ple_gate, w_ple_proj, norm_final):
    h = x
    split_at = [S5_WIDTH, S5_WIDTH + SGU_WIDTH, S5_WIDTH + 2 * SGU_WIDTH, S5_WIDTH + 2 * SGU_WIDTH + D_MODEL]
    for i in range(DEPTH):
        xn = rms_norm(h, norm_mix[i])
        proj = xn @ w_in[i]
        x_s5, u_sgu, v_sgu, g_s5, g_sgu = jnp.split(proj, split_at, axis=-1)
        out_a = s5_branch(x_s5, s5_a_re[i], s5_a_im[i], s5_log_dt[i], s5_b_re[i], s5_b_im[i],
                          s5_c_re[i], s5_c_im[i], s5_d[i], w_glu[i])
        out_b = sgu_branch(u_sgu, v_sgu, sgu_norm[i], sgu_w[i], sgu_b[i], w_sgu_proj[i])
        merged = jax.nn.sigmoid(g_s5) * out_a + jax.nn.sigmoid(g_sgu) * out_b
        h = h + merged @ w_out[i]
        h = h + hier_moe(rms_norm(h, norm_ffn[i]), w_router_group[i], b_router_group[i],
                         w_router_expert[i], b_router_expert[i], w_expert_gate[i],
                         w_expert_up[i], w_expert_down[i])
        gate = jax.nn.sigmoid(rms_norm(h, norm_ple[i]) @ w_ple_gate[i])
        h = h + (p[i] @ w_ple_proj[i]) * gate
    return rms_norm(h, norm_final)
```

```cpp
#include <hip/hip_runtime.h>
#include <cstdio>

#ifndef MK_ONE_LAUNCH
#define MK_ONE_LAUNCH 0
#endif

#define LAS __attribute__((address_space(3)))
#define GAS __attribute__((address_space(1)))
typedef _Float16 f16;
typedef _Float16 f16x2 __attribute__((ext_vector_type(2)));
typedef _Float16 f16x4 __attribute__((ext_vector_type(4)));
typedef _Float16 f16x8 __attribute__((ext_vector_type(8)));
typedef float f32x2 __attribute__((ext_vector_type(2)));
typedef float f32x4 __attribute__((ext_vector_type(4)));
typedef unsigned u32x2 __attribute__((ext_vector_type(2)));
typedef unsigned u32x4 __attribute__((ext_vector_type(4)));
typedef unsigned long long u64;
typedef GAS unsigned gu32;

constexpr int BATCH = 16, SEQ = 2048, DM = 1024, T = BATCH * SEQ;
constexpr int CHK = 32, NCHK = SEQ / CHK;
constexpr int AK = 640;
constexpr float EPS = 1e-6f;
constexpr int NWAVES = 8;
constexpr float SSQ_SCALE = 16777216.0f;

constexpr size_t MiB = 1u << 20;
constexpr size_t WS_CTL = 0, CTL_ZERO_BYTES = 2 * MiB;
constexpr size_t WS_W = 2 * MiB;
constexpr size_t W_IN = 0, W_V = 6 * MiB, W_GLU = 7 * MiB, W_SP = 9 * MiB, W_OUT = 10 * MiB, W_PG = 12 * MiB, W_PP = 14 * MiB,
                 W_R = 14 * MiB + 512 * 1024, W_SM = 14 * MiB + 768 * 1024, W_S5A = 15 * MiB, W_S5B = 23 * MiB, W_GU = 43 * MiB, W_D = 107 * MiB;
constexpr size_t WS_SMALL = 141 * MiB;
constexpr size_t WS_HB = 142 * MiB;
constexpr size_t WS_H16 = 270 * MiB;
constexpr size_t WS_P16 = 334 * MiB;
constexpr size_t WS_RS = 350 * MiB;
constexpr size_t WS_RSM = 350 * MiB + 512 * 1024;
constexpr size_t WS_LDST = 351 * MiB, WS_LW = 355 * MiB, WS_LRS = 359 * MiB;
constexpr size_t WS_SST = 363 * MiB;
constexpr size_t WS_ACT = 379 * MiB;
constexpr size_t A_AEXT = 0, A_U16 = 40 * MiB, A_VT = 72 * MiB, A_GA = 104 * MiB, A_GB = 168 * MiB;
constexpr size_t A_HID = 0, A_C16 = 72 * MiB, A_PP = 0;
constexpr size_t WS_END = 379 * MiB + 232 * MiB;
constexpr int CW_BAR = 4096;
constexpr int CW_CNT = 8192;
constexpr size_t CTL_SSQ0 = 256 * 1024, CTL_SSQ1 = 512 * 1024, CTL_SSQ2 = 768 * 1024;

constexpr int RING_BYTES = 131072;
constexpr int LDSX_OFF = RING_BYTES;
constexpr int MISC_OFF = RING_BYTES + 1024;
constexpr int LDS_BYTES = 147456;

#define LDS_WAIT() asm volatile("s_waitcnt lgkmcnt(0)" ::: "memory")
#define VM_WAIT() asm volatile("s_waitcnt vmcnt(0)" ::: "memory")
__device__ __forceinline__ float fexp2(float x) { return __builtin_amdgcn_exp2f(x); }
__device__ __forceinline__ float frcp(float x) { return __builtin_amdgcn_rcpf(x); }
__device__ __forceinline__ float sigm(float x) { return frcp(1.0f + fexp2(-1.4426950409f * x)); }
__device__ __forceinline__ float gelu_t(float x) { const float u = x + 0.044715f * x * x * x; return x * frcp(1.0f + fexp2(-2.3022082f * u)); }
__device__ __forceinline__ float silu_f(float x) { return x * sigm(x); }
__device__ __forceinline__ unsigned pkh(float a, float b) { f16x2 v; v.x = (f16)a; v.y = (f16)b; return __builtin_bit_cast(unsigned, v); }
__device__ __forceinline__ u32x4 pk8(const f32x4 a, const f32x4 b) { u32x4 w; w.x = pkh(a[0], a[1]); w.y = pkh(a[2], a[3]); w.z = pkh(b[0], b[1]); w.w = pkh(b[2], b[3]); return w; }
__device__ __forceinline__ void unpk8(const u32x4 w, f32x4& a, f32x4& b) {
    const f16x8 h = __builtin_bit_cast(f16x8, w);
    a = (f32x4){(float)h[0], (float)h[1], (float)h[2], (float)h[3]}; b = (f32x4){(float)h[4], (float)h[5], (float)h[6], (float)h[7]};
}
__device__ __forceinline__ float wave_sum(float v) {
#pragma unroll
    for (int o = 1; o < 64; o <<= 1) v += __shfl_xor(v, o);
    return v;
}
__device__ __forceinline__ float rstd_u64(const u64* p, int row) { const float s = (float)p[row] * (1.0f / SSQ_SCALE); return 1.0f / sqrtf(s * (1.0f / DM) + EPS); }

namespace pg8 {
constexpr int BM = 256, BK = 64, HALF = 128, HTB = HALF * BK * 2, STAGE_BYTES = 8 * HTB, NXCD = 8, WGM = 8;
__device__ __forceinline__ int lds_byte(int r, int c) { const int st = (r >> 4) * 2 + (c >> 5), rr = r & 15, cc = c & 31, ob = rr * 64 + cc * 2; return st * 1024 + (ob ^ (((ob >> 9) & 1) << 5)); }
__device__ __forceinline__ void stage_rc(int b, int& R, int& C) { const int st = b / 1024, sb = b % 1024, swz = sb ^ (((sb >> 9) & 1) << 5); R = (st >> 1) * 16 + swz / 64; C = (st & 1) * 32 + (swz % 64) / 2; }
__device__ __forceinline__ int perm32(int rho) { const int n = rho >> 4, i = rho & 15; return 8 * (i >> 2) + 4 * n + (i & 3); }

struct Unit { int pm, pn, g, aux, mt; };

struct SchedStd {
    int nM, nN, nwg, G, c; const char* A; const char* B; size_t ta, tb;
    __device__ __forceinline__ void init(int nM_, int nN_, int G_, int c_, const void* A_, const void* B_, size_t ta_, size_t tb_) { nM = nM_; nN = nN_; nwg = nM * nN; G = G_; c = c_; A = (const char*)A_; B = (const char*)B_; ta = ta_; tb = tb_; }
    __device__ __forceinline__ bool next(int i, Unit& u) const {
        const long L = (long)i * G + c; if (L >= nwg) return false;
        int wgid = (int)L; { const int q = nwg / NXCD, r = nwg % NXCD, xcd = wgid % NXCD, off = wgid / NXCD; wgid = (xcd < r ? xcd * (q + 1) : r * (q + 1) + (xcd - r) * q) + off; }
        const int nig = WGM * nN, gid = wgid / nig, fm = gid * WGM, gsz = (nM - fm) < WGM ? (nM - fm) : WGM;
        u.pm = fm + ((wgid % nig) % gsz); u.pn = (wgid % nig) / gsz; u.g = 0; u.aux = 0; u.mt = 0; return true;
    }
    __device__ __forceinline__ const char* a_ptr(const Unit& u) const { return A + (size_t)u.pm * ta; }
    __device__ __forceinline__ const char* b_ptr(const Unit& u) const { return B + (size_t)u.pn * tb; }
    __device__ __forceinline__ unsigned a_row(const Unit&, int) const { return 0u; }
};
struct SchedGrp {
    int nPM, nPN, ntot, G, c; const char* A; const char* B; size_t ga, gb, ta, tb;
    __device__ __forceinline__ bool next(int i, Unit& u) const {
        const int L = i * G + c; if (L >= ntot) return false;
        const int per = nPM * nPN; u.g = L / per; const int r = L % per; u.pn = r / nPM; u.pm = r % nPM; u.aux = 0; u.mt = 0; return true;
    }
    __device__ __forceinline__ const char* a_ptr(const Unit& u) const { return A + (size_t)u.g * ga + (size_t)u.pm * ta; }
    __device__ __forceinline__ const char* b_ptr(const Unit& u) const { return B + (size_t)u.g * gb + (size_t)u.pn * tb; }
    __device__ __forceinline__ unsigned a_row(const Unit&, int) const { return 0u; }
};
struct SchedMoE {
    const LAS int* tbl; const int* cnt; const int* ldst; int G, c; const char* A; const char* B; size_t ta, eb, tbB; bool gather;
    __device__ __forceinline__ bool next(int i, Unit& u) const {
        const int L = i * G + c; const int mt = L >> 2; const int tot = __builtin_amdgcn_readfirstlane(tbl[32]);
        if (mt >= tot) return false;
        int e = 0;
        for (int k = 1; k < 32; ++k) { const int s = __builtin_amdgcn_readfirstlane(tbl[k]); if (mt >= s) e = k; }
        u.g = e; u.pm = mt - __builtin_amdgcn_readfirstlane(tbl[e]); u.pn = L & 3; u.aux = __builtin_amdgcn_readfirstlane(cnt[e]); u.mt = mt; return true;
    }
    __device__ __forceinline__ const char* a_ptr(const Unit& u) const { return gather ? A : A + (size_t)u.mt * ta; }
    __device__ __forceinline__ const char* b_ptr(const Unit& u) const { return B + (size_t)u.g * eb + (size_t)u.pn * tbB; }
    __device__ __forceinline__ unsigned a_row(const Unit& u, int r) const { const int pos = u.pm * 256 + r; return pos < u.aux ? (unsigned)(ldst[(size_t)u.g * T + pos] >> 1) : 0u; }
};

template <class Epi, class Sched, bool GATHER>
__device__ __forceinline__ void gemm_phase(LAS unsigned char* lds, const int nt, const unsigned lda, const unsigned ldb, const Sched& S, const Epi& E) {
    const int tid = threadIdx.x, wid = __builtin_amdgcn_readfirstlane(tid >> 6), lane = tid & 63, wr = wid >> 2, wc = wid & 3, fr = lane & 15, fq = lane >> 4;
    unsigned voffB[2], ccA[2]; int rA[2];
#pragma unroll
    for (int i = 0; i < 2; ++i) { int R, C; stage_rc(tid * 16 + i * 8192, R, C); const int Rb = (R & ~31) + perm32(R & 31);
        voffB[i] = (unsigned)Rb * ldb + (unsigned)C * 2u; rA[i] = R; ccA[i] = (unsigned)C * 2u; }
    const size_t kstep = (size_t)(BK * 2);
    const size_t hstepB = (size_t)HALF * ldb;
    const unsigned ldsw = (unsigned)wid * 1024u;
    const int aoff = lds_byte(wr * 64 + fr, fq * 8), boff = lds_byte(wc * 32 + fr, fq * 8);
#define PG8_SA(b, h) (((b) * 2 + (h)) * HTB)
#define PG8_SB(b, h) ((4 + (b) * 2 + (h)) * HTB)
#define PG8_STAGE_B(bufoff, gbase) do { _Pragma("unroll") for (int _i = 0; _i < 2; ++_i) \
        __builtin_amdgcn_global_load_lds((const unsigned*)((const char*)(gbase) + voffB[_i]), (LAS unsigned*)(lds + (bufoff) + ldsw + _i * 8192), 16, 0, 0); } while (0)
#define PG8_STAGE_A(bufoff, gbase, o0, o1) do { \
        __builtin_amdgcn_global_load_lds((const unsigned*)((const char*)(gbase) + (o0)), (LAS unsigned*)(lds + (bufoff) + ldsw), 16, 0, 0); \
        __builtin_amdgcn_global_load_lds((const unsigned*)((const char*)(gbase) + (o1)), (LAS unsigned*)(lds + (bufoff) + ldsw + 8192), 16, 0, 0); } while (0)
#define PG8_LDA(dst, b, h) do { _Pragma("unroll") for (int m = 0; m < 4; ++m) _Pragma("unroll") for (int k = 0; k < 2; ++k) dst[m][k] = *(const LAS f16x8*)(lds + PG8_SA(b, h) + aoff + m * 2048 + k * 1024); } while (0)
#define PG8_LDB(dst, b, h) do { _Pragma("unroll") for (int n = 0; n < 2; ++n) _Pragma("unroll") for (int k = 0; k < 2; ++k) dst[n][k] = *(const LAS f16x8*)(lds + PG8_SB(b, h) + boff + n * 2048 + k * 1024); } while (0)
#define PG8_MMA(ai, bj, At, Bt) do { __builtin_amdgcn_s_setprio(1); _Pragma("unroll") for (int m = 0; m < 4; ++m) _Pragma("unroll") for (int n = 0; n < 2; ++n) _Pragma("unroll") for (int k = 0; k < 2; ++k) \
        acc[ai][bj][m][n] = __builtin_amdgcn_mfma_f32_16x16x32_f16(Bt[n][k], At[m][k], acc[ai][bj][m][n], 0, 0, 0); __builtin_amdgcn_s_setprio(0); } while (0)
#define PG8_WAIT_V(n) asm volatile("s_waitcnt vmcnt(" #n ")" ::: "memory")
#define PG8_WAIT_L(n) asm volatile("s_waitcnt lgkmcnt(" #n ")" ::: "memory")
#define PG8_BAR __builtin_amdgcn_s_barrier()
#define PG8_SCHED __builtin_amdgcn_sched_barrier(0)
#define PG8_SETOFF(o, u) do { _Pragma("unroll") for (int _h = 0; _h < 2; ++_h) _Pragma("unroll") for (int _i = 0; _i < 2; ++_i) \
        o[_h][_i] = (GATHER ? S.a_row(u, rA[_i] + 128 * _h) : (unsigned)(rA[_i] + 128 * _h)) * lda + ccA[_i]; } while (0)
    Unit cur, nxt; int ui = 0;
    if (!S.next(0, cur)) return;
    f32x4 acc[2][2][4][2];
#pragma unroll
    for (int a = 0; a < 2; ++a)
#pragma unroll
        for (int b = 0; b < 2; ++b)
#pragma unroll
            for (int m = 0; m < 4; ++m)
#pragma unroll
                for (int n = 0; n < 2; ++n) acc[a][b][m][n] = (f32x4){0.f, 0.f, 0.f, 0.f};
    f16x8 At[4][2], B0[2][2], B1[2][2];
    unsigned oC[2][2], oN[2][2];
    PG8_SETOFF(oC, cur);
    const char* cA = S.a_ptr(cur); const char* cB = S.b_ptr(cur);
    PG8_STAGE_B(PG8_SB(0, 0), cB); PG8_STAGE_B(PG8_SB(0, 1), cB + hstepB); PG8_STAGE_A(PG8_SA(0, 0), cA, oC[0][0], oC[0][1]); PG8_STAGE_A(PG8_SA(0, 1), cA, oC[1][0], oC[1][1]);
    if (wr == 1) PG8_BAR;
    PG8_WAIT_V(2); PG8_BAR;
    PG8_STAGE_B(PG8_SB(1, 0), cB + kstep); PG8_STAGE_A(PG8_SA(1, 0), cA + kstep, oC[0][0], oC[0][1]); PG8_STAGE_B(PG8_SB(1, 1), cB + hstepB + kstep);
    PG8_WAIT_V(6); PG8_BAR;
    for (;;) {
        const bool has_next = S.next(ui + 1, nxt);
        const char* nA = has_next ? S.a_ptr(nxt) : cA; const char* nB = has_next ? S.b_ptr(nxt) : cB;
        if (GATHER) { if (has_next) { PG8_SETOFF(oN, nxt); } else {
#pragma unroll
            for (int _h = 0; _h < 2; ++_h)
#pragma unroll
                for (int _i = 0; _i < 2; ++_i) oN[_h][_i] = oC[_h][_i]; } }
#pragma clang loop unroll(disable)
        for (int t = 0; t < nt; t += 2) {
            const bool last = (t == nt - 2);
            const char* a1 = cA + (size_t)(t + 1) * kstep;
            const char* a2 = last ? nA : cA + (size_t)(t + 2) * kstep; const char* b2 = last ? nB : cB + (size_t)(t + 2) * kstep;
            const char* a3 = a2 + kstep; const char* b3 = b2 + kstep;
            unsigned x00 = oC[0][0], x01 = oC[0][1], x10 = oC[1][0], x11 = oC[1][1];
            if (GATHER) { x00 = last ? oN[0][0] : x00; x01 = last ? oN[0][1] : x01; x10 = last ? oN[1][0] : x10; x11 = last ? oN[1][1] : x11; }
            PG8_LDB(B0, 0, 0); PG8_LDB(B1, 0, 1); PG8_SCHED; PG8_LDA(At, 0, 0); PG8_STAGE_A(PG8_SA(1, 1), a1, oC[1][0], oC[1][1]);
            PG8_WAIT_V(8); PG8_WAIT_L(0); PG8_BAR; PG8_MMA(0, 0, At, B0); PG8_MMA(0, 1, At, B1); PG8_BAR; PG8_SCHED;
            PG8_LDA(At, 0, 1); PG8_STAGE_B(PG8_SB(0, 0), b2); PG8_STAGE_B(PG8_SB(0, 1), b2 + hstepB); PG8_STAGE_A(PG8_SA(0, 0), a2, x00, x01);
            PG8_WAIT_V(8); PG8_WAIT_L(0); PG8_BAR; PG8_MMA(1, 0, At, B0); PG8_MMA(1, 1, At, B1); PG8_BAR; PG8_SCHED;
            PG8_LDB(B0, 1, 0); PG8_LDB(B1, 1, 1); PG8_SCHED; PG8_LDA(At, 1, 0); PG8_STAGE_A(PG8_SA(0, 1), a2, x10, x11);
            PG8_WAIT_V(8); PG8_WAIT_L(0); PG8_BAR; PG8_MMA(0, 0, At, B0); PG8_MMA(0, 1, At, B1); PG8_BAR; PG8_SCHED;
            PG8_LDA(At, 1, 1); PG8_STAGE_B(PG8_SB(1, 0), b3); PG8_STAGE_B(PG8_SB(1, 1), b3 + hstepB); PG8_STAGE_A(PG8_SA(1, 0), a3, x00, x01);
            PG8_WAIT_V(8); PG8_WAIT_L(0); PG8_BAR; PG8_MMA(1, 0, At, B0); PG8_MMA(1, 1, At, B1); PG8_BAR; PG8_SCHED;
        }
        if (wr == 0) PG8_BAR;
        E(acc, cur, wr, wc, fr, fq);
        if (!has_next) break;
#pragma unroll
        for (int a = 0; a < 2; ++a)
#pragma unroll
            for (int b = 0; b < 2; ++b)
#pragma unroll
                for (int m = 0; m < 4; ++m)
#pragma unroll
                    for (int n = 0; n < 2; ++n) acc[a][b][m][n] = (f32x4){0.f, 0.f, 0.f, 0.f};
        cur = nxt; cA = nA; cB = nB; ++ui;
        if (GATHER) {
#pragma unroll
            for (int _h = 0; _h < 2; ++_h)
#pragma unroll
                for (int _i = 0; _i < 2; ++_i) oC[_h][_i] = oN[_h][_i]; }
        if (wr == 1) PG8_BAR;
    }
    PG8_WAIT_V(0);
    PG8_BAR;
#undef PG8_SA
#undef PG8_SB
#undef PG8_STAGE_A
#undef PG8_STAGE_B
#undef PG8_LDA
#undef PG8_LDB
#undef PG8_MMA
#undef PG8_WAIT_V
#undef PG8_WAIT_L
#undef PG8_BAR
#undef PG8_SCHED
#undef PG8_SETOFF
}
}
using pg8::Unit;
typedef f32x4 AccT[2][2][4][2];

#define EPI_ROWS_BEGIN _Pragma("unroll") for (int ai = 0; ai < 2; ++ai) _Pragma("unroll") for (int m = 0; m < 4; ++m) { int rt_ = 128 * ai + 64 * wr + 16 * m + fr; asm volatile("" : "+v"(rt_)); const int rt = rt_;
#define EPI_ROWS_END asm volatile("" ::: "memory"); }

struct EpiP1Main {
    const float* rsm; f16* aext; f16* u16; f16* ga; f16* gb;
    __device__ __forceinline__ void operator()(const AccT& acc, const Unit& u, int wr, int wc, int fr, int fq) const {
        const int pn = u.pn;
        EPI_ROWS_BEGIN
            const int tk = u.pm * 256 + rt; const float rs = rsm[tk];
#pragma unroll
            for (int bj = 0; bj < 2; ++bj) {
                const int c = 128 * bj + 32 * wc + 8 * fq; f32x4 v0 = acc[ai][bj][m][0] * rs, v1 = acc[ai][bj][m][1] * rs;
                if (pn < 2) {
                    const int cg = pn * 256 + c, g = cg >> 4, ch0 = cg & 15, b = tk >> 11, l = tk & 2047, k = l >> 5, tl = l & 31;
                    *(u32x4*)(aext + ((size_t)(g * 1024 + b * 64 + k) * AK + 128 + tl * 16 + ch0)) = pk8(v0, v1);
                } else if (pn < 4) {
#pragma unroll
                    for (int j = 0; j < 4; ++j) { v0[j] = gelu_t(v0[j]); v1[j] = gelu_t(v1[j]); }
                    *(u32x4*)(u16 + (size_t)tk * 512 + (pn - 2) * 256 + c) = pk8(v0, v1);
                } else {
#pragma unroll
                    for (int j = 0; j < 4; ++j) { v0[j] = sigm(v0[j]); v1[j] = sigm(v1[j]); }
                    f16* dst = (pn < 8) ? ga + (size_t)tk * 1024 + (pn - 4) * 256 + c : gb + (size_t)tk * 1024 + (pn - 8) * 256 + c;
                    *(u32x4*)dst = pk8(v0, v1);
                }
            }
        EPI_ROWS_END
    }
};
struct EpiP1VT {
    const float* rsm; f16* vt;
    __device__ __forceinline__ void operator()(const AccT& acc, const Unit& u, int wr, int wc, int fr, int fq) const {
        EPI_ROWS_BEGIN
            const int row = u.pm * 256 + rt;
#pragma unroll
            for (int bj = 0; bj < 2; ++bj) {
                const f32x4 r0 = *(const f32x4*)(rsm + u.pn * 256 + 128 * bj + 32 * wc + 8 * fq), r1 = *(const f32x4*)(rsm + u.pn * 256 + 128 * bj + 32 * wc + 8 * fq + 4);
                f32x4 v0 = acc[ai][bj][m][0] * r0, v1 = acc[ai][bj][m][1] * r1;
#pragma unroll
                for (int j = 0; j < 4; ++j) { v0[j] = gelu_t(v0[j]); v1[j] = gelu_t(v1[j]); }
                *(u32x4*)(vt + (size_t)row * T + u.pn * 256 + 128 * bj + 32 * wc + 8 * fq) = pk8(v0, v1);
            }
        EPI_ROWS_END
    }
};
struct EpiS5a {
    float* sst;
    __device__ __forceinline__ void operator()(const AccT& acc, const Unit& u, int wr, int wc, int fr, int fq) const {
        EPI_ROWS_BEGIN
            float* dst = sst + ((size_t)(u.g * 1024 + u.pm * 256 + rt) * 128 + 32 * wc + 8 * fq);
            *(f32x4*)dst = acc[ai][0][m][0] * (1.0f / 256.0f); *(f32x4*)(dst + 4) = acc[ai][0][m][1] * (1.0f / 256.0f);
        EPI_ROWS_END
    }
};
struct EpiS5b {
    const f16* aext; const float* dsk; f16* y16;
    __device__ __forceinline__ void operator()(const AccT& acc, const Unit& u, int wr, int wc, int fr, int fq) const {
        EPI_ROWS_BEGIN
            const int R = u.pm * 256 + rt, b = R >> 6, k = R & 63;
#pragma unroll
            for (int bj = 0; bj < 2; ++bj) {
                const int col = u.pn * 256 + 128 * bj + 32 * wc + 8 * fq, tl = col >> 4, ch0 = col & 15;
                f32x4 x0, x1; unpk8(*(const u32x4*)(aext + ((size_t)(u.g * 1024 + R) * AK + 128 + col)), x0, x1);
                const f32x4 d0 = *(const f32x4*)(dsk + u.g * 16 + ch0), d1 = *(const f32x4*)(dsk + u.g * 16 + ch0 + 4);
                f32x4 v0 = acc[ai][bj][m][0] * (1.0f / 64.0f) + d0 * x0, v1 = acc[ai][bj][m][1] * (1.0f / 64.0f) + d1 * x1;
#pragma unroll
                for (int j = 0; j < 4; ++j) { v0[j] = gelu_t(v0[j]); v1[j] = gelu_t(v1[j]); }
                *(u32x4*)(y16 + ((size_t)(b * 2048 + k * 32 + tl) * 512 + u.g * 16 + ch0)) = pk8(v0, v1);
            }
        EPI_ROWS_END
    }
};
struct EpiP3a {
    f16* gb;
    __device__ __forceinline__ void operator()(const AccT& acc, const Unit& u, int wr, int wc, int fr, int fq) const {
        EPI_ROWS_BEGIN
            const int tk = u.pm * 256 + rt;
#pragma unroll
            for (int bj = 0; bj < 2; ++bj) {
                f16* p = gb + (size_t)tk * 1024 + u.pn * 256 + 128 * bj + 32 * wc + 8 * fq;
                f32x4 g0, g1; unpk8(*(const u32x4*)p, g0, g1);
                *(u32x4*)p = pk8(g0 * acc[ai][bj][m][0], g1 * acc[ai][bj][m][1]);
            }
        EPI_ROWS_END
    }
};
struct EpiP3b {
    const f16* ga; f16* gb;
    __device__ __forceinline__ void operator()(const AccT& acc, const Unit& u, int wr, int wc, int fr, int fq) const {
        EPI_ROWS_BEGIN
            const int tk = u.pm * 256 + rt; const size_t off = (size_t)tk * 1024 + u.pn * 128 + 32 * wc + 8 * fq;
            f32x4 a0, a1, t0, t1; unpk8(*(const u32x4*)(ga + off), a0, a1); unpk8(*(const u32x4*)(gb + off), t0, t1);
            f32x4 v0 = acc[ai][0][m][0], v1 = acc[ai][0][m][1]; const f32x4 z0 = acc[ai][1][m][0], z1 = acc[ai][1][m][1];
#pragma unroll
            for (int j = 0; j < 4; ++j) { v0[j] = a0[j] * (v0[j] * sigm(z0[j])) + t0[j]; v1[j] = a1[j] * (v1[j] * sigm(z1[j])) + t1[j]; }
            *(u32x4*)(gb + off) = pk8(v0, v1);
        EPI_ROWS_END
    }
};
struct EpiP4 {
    const float* hin; float* hb; f16* h16;
    __device__ __forceinline__ void operator()(const AccT& acc, const Unit& u, int wr, int wc, int fr, int fq) const {
        EPI_ROWS_BEGIN
            const int tk = u.pm * 256 + rt;
#pragma unroll
            for (int bj = 0; bj < 2; ++bj) {
                const size_t off = (size_t)tk * 1024 + u.pn * 256 + 128 * bj + 32 * wc + 8 * fq;
                const f32x4 v0 = *(const f32x4*)(hin + off) + acc[ai][bj][m][0], v1 = *(const f32x4*)(hin + off + 4) + acc[ai][bj][m][1];
                *(f32x4*)(hb + off) = v0; *(f32x4*)(hb + off + 4) = v1; *(u32x4*)(h16 + off) = pk8(v0, v1);
            }
        EPI_ROWS_END
    }
};
struct EpiP7 {
    const float* lrs; f16* hid;
    __device__ __forceinline__ void operator()(const AccT& acc, const Unit& u, int wr, int wc, int fr, int fq) const {
        EPI_ROWS_BEGIN
            const int pos = u.pm * 256 + rt;
            if (pos < u.aux) {
                const float rs = lrs[(size_t)u.g * T + pos];
                f32x4 g0 = acc[ai][0][m][0] * rs, g1 = acc[ai][0][m][1] * rs; const f32x4 p0 = acc[ai][1][m][0] * rs, p1 = acc[ai][1][m][1] * rs;
#pragma unroll
                for (int j = 0; j < 4; ++j) { g0[j] = silu_f(g0[j]) * p0[j]; g1[j] = silu_f(g1[j]) * p1[j]; }
                *(u32x4*)(hid + ((size_t)(u.mt * 256 + rt) * 512 + u.pn * 128 + 32 * wc + 8 * fq)) = pk8(g0, g1);
            }
        EPI_ROWS_END
    }
};
struct EpiP8 {
    const int* ldst; const float* lw; f16* c16;
    __device__ __forceinline__ void operator()(const AccT& acc, const Unit& u, int wr, int wc, int fr, int fq) const {
        EPI_ROWS_BEGIN
            const int pos = u.pm * 256 + rt;
            if (pos < u.aux) {
                const int dst = ldst[(size_t)u.g * T + pos]; const float w = lw[(size_t)u.g * T + pos];
#pragma unroll
                for (int bj = 0; bj < 2; ++bj)
                    *(u32x4*)(c16 + ((size_t)dst * 1024 + u.pn * 256 + 128 * bj + 32 * wc + 8 * fq)) = pk8(acc[ai][bj][m][0] * w, acc[ai][bj][m][1] * w);
            }
        EPI_ROWS_END
    }
};
struct EpiPP {
    f16* pp;
    __device__ __forceinline__ void operator()(const AccT& acc, const Unit& u, int wr, int wc, int fr, int fq) const {
        EPI_ROWS_BEGIN
            const int tk = u.pm * 256 + rt;
#pragma unroll
            for (int bj = 0; bj < 2; ++bj)
                *(u32x4*)(pp + ((size_t)tk * 1024 + u.pn * 256 + 128 * bj + 32 * wc + 8 * fq)) = pk8(acc[ai][bj][m][0], acc[ai][bj][m][1]);
        EPI_ROWS_END
    }
};
struct EpiP10 {
    const float* rsple; const f16* pp; const float* hin; float* hout; f16* h16; u64* ssq;
    __device__ __forceinline__ void operator()(const AccT& acc, const Unit& u, int wr, int wc, int fr, int fq) const {
        EPI_ROWS_BEGIN
            const int tk = u.pm * 256 + rt; const float rs = rsple[tk]; float sq = 0.f;
#pragma unroll
            for (int bj = 0; bj < 2; ++bj) {
                const size_t off = (size_t)tk * 1024 + u.pn * 256 + 128 * bj + 32 * wc + 8 * fq;
                f32x4 p0, p1; unpk8(*(const u32x4*)(pp + off), p0, p1);
                f32x4 v0 = *(const f32x4*)(hin + off), v1 = *(const f32x4*)(hin + off + 4);
                const f32x4 a0 = acc[ai][bj][m][0] * rs, a1 = acc[ai][bj][m][1] * rs;
#pragma unroll
                for (int j = 0; j < 4; ++j) { v0[j] += p0[j] * sigm(a0[j]); v1[j] += p1[j] * sigm(a1[j]); sq += v0[j] * v0[j] + v1[j] * v1[j]; }
                *(f32x4*)(hout + off) = v0; *(f32x4*)(hout + off + 4) = v1; *(u32x4*)(h16 + off) = pk8(v0, v1);
            }
            sq += __shfl_xor(sq, 16); sq += __shfl_xor(sq, 32);
            if (fq == 0) atomicAdd(ssq + tk, (u64)(sq * SSQ_SCALE));
        EPI_ROWS_END
    }
};

#define XB_TMO      128
#define XB_XCNT(j)  (256  + 64 * (j))
#define XB_XSUB(j)  (1280 + 64 * (j))
#define XB_XGEN(j)  (2304 + 64 * (j))
#define XB_TOP      3328
#define XB_TOPGEN   3392
#define XCD_BAR_WORDS 3456
#define XB_SPIN_CAP (1u << 18)
__device__ __forceinline__ unsigned xb_ld(unsigned* p)              { return __hip_atomic_load(p, __ATOMIC_RELAXED, __HIP_MEMORY_SCOPE_AGENT); }
__device__ __forceinline__ unsigned xb_add(unsigned* p, unsigned v) { return __hip_atomic_fetch_add(p, v, __ATOMIC_RELAXED, __HIP_MEMORY_SCOPE_AGENT); }
__device__ __forceinline__ unsigned xb_xcc_id() { return (unsigned)__builtin_amdgcn_s_getreg((3 << 11) | 20) & 0xFu; }
#define XB_SPIN(cond, bar) do { unsigned _sp = 0; while (cond) { __builtin_amdgcn_s_sleep(1); \
    if ((++_sp & 255u) == 0u) { if (xb_ld(&(bar)[XB_TMO])) break; if (_sp > XB_SPIN_CAP) { atomicAdd(&(bar)[XB_TMO], 1u); break; } } } } while (0)
struct XcdBarrier { unsigned* bar; unsigned x; volatile LAS unsigned* st; };
__device__ __forceinline__ XcdBarrier xcd_barrier_post(unsigned* bar, volatile LAS unsigned* st) {
    XcdBarrier b; b.bar = bar; b.x = xb_xcc_id(); b.st = st;
    if (threadIdx.x == 0) (void)xb_add(&bar[XB_XCNT(b.x)], 1u);
    return b;
}
__device__ __forceinline__ void xcd_barrier_complete(unsigned* bar, unsigned x, unsigned& nloc, unsigned& nx) {
    const unsigned G = gridDim.x * gridDim.y * gridDim.z;
    unsigned sum, cnt, mine, sp = 0u;
    for (;;) {
        sum = 0u; cnt = 0u; mine = 0u;
#pragma unroll
        for (unsigned j = 0; j < 16; ++j) { const unsigned c = xb_ld(&bar[XB_XCNT(j)]); sum += c; cnt += (c > 0u) ? 1u : 0u; }
        mine = xb_ld(&bar[XB_XCNT(x)]);
        if (sum == G) break;
        __builtin_amdgcn_s_sleep(1);
        if ((++sp & 255u) == 0u) { if (xb_ld(&bar[XB_TMO])) break; if (sp > XB_SPIN_CAP) { atomicAdd(&bar[XB_TMO], 1u); break; } }
    }
    nloc = mine > 0u ? mine : 1u; nx = cnt > 0u ? cnt : 1u;
}
__device__ __forceinline__ void xcd_barrier(const XcdBarrier& b) {
    asm volatile("s_waitcnt vmcnt(0)" ::: "memory");
    __syncthreads();
    if (threadIdx.x == 0) {
        unsigned* bar = b.bar;
        __builtin_amdgcn_s_waitcnt(0);
        unsigned nloc = b.st[0], nx = b.st[1];
        if (nloc == 0u) { xcd_barrier_complete(bar, b.x, nloc, nx); b.st[0] = nloc; b.st[1] = nx; }
        const unsigned old = xb_add(&bar[XB_XSUB(b.x)], 1u);
        const unsigned gen = old / nloc;
        if (old + 1u == (gen + 1u) * nloc) {
            __builtin_amdgcn_fence(__ATOMIC_RELEASE, "agent");
            asm volatile("s_waitcnt vmcnt(0)" ::: "memory");
            const unsigned og = xb_add(&bar[XB_TOP], 1u);
            const unsigned tg = og / nx;
            if (og + 1u == (tg + 1u) * nx) xb_add(&bar[XB_TOPGEN], 1u);
            else XB_SPIN(xb_ld(&bar[XB_TOPGEN]) == tg, bar);
            __builtin_amdgcn_fence(__ATOMIC_ACQUIRE, "agent");
            xb_add(&bar[XB_XGEN(b.x)], 1u);
            asm volatile("s_waitcnt vmcnt(0)" ::: "memory");
        } else {
            XB_SPIN(xb_ld(&bar[XB_XGEN(b.x)]) == gen, bar);
            __builtin_amdgcn_fence(__ATOMIC_ACQUIRE, "agent");
            asm volatile("s_waitcnt vmcnt(0)" ::: "memory");
        }
    }
    __syncthreads();
}

struct Args { const float* in[30]; float* out; unsigned char* ws; int ph_lo, ph_hi; };
struct Ctx {
    LAS unsigned char* lds; unsigned char* ws; const float* const* in; float* out;
    int tid, lane, wave, vcu, G, gw, NGW;
};
enum { I_X = 0, I_P, I_NMIX, I_WIN, I_AR, I_AI, I_LDT, I_BR, I_BI, I_CR, I_CI, I_D, I_WGLU, I_SGN, I_SGW, I_SGB, I_WSP, I_WOUT, I_NFFN, I_WRG, I_BRG, I_WRE, I_BRE, I_WEG, I_WEU, I_WED, I_NPLE, I_WPG, I_WPP, I_NFIN };

__device__ __forceinline__ void tr_item(const float* W, int ldn, int K, const float* scale, f16* WT, int dst_row0, LAS float* scr, int k0, int n0, int lane) {
#pragma unroll 8
    for (int i = 0; i < 32; ++i) { const int kk = 2 * i + (lane >> 5); float v = W[(size_t)(k0 + kk) * ldn + n0 + (lane & 31)]; if (scale) v *= scale[k0 + kk]; scr[kk * 33 + (lane & 31)] = v; }
    LDS_WAIT(); asm volatile("" ::: "memory");
    const int c = lane & 7;
#pragma unroll
    for (int j = 0; j < 4; ++j) { const int n = (lane >> 3) + 8 * j; const LAS float* s = scr + (8 * c) * 33 + n;
        u32x4 o; o.x = pkh(s[0 * 33], s[1 * 33]); o.y = pkh(s[2 * 33], s[3 * 33]); o.z = pkh(s[4 * 33], s[5 * 33]); o.w = pkh(s[6 * 33], s[7 * 33]);
        *(u32x4*)(WT + (size_t)(dst_row0 + n) * K + k0 + 8 * c) = o; }
    LDS_WAIT(); asm volatile("" ::: "memory");
}
__device__ __forceinline__ int map_win(int n) { return n < 1024 ? n : (n < 1536 ? 3072 + (n - 1024) : n - 512); }
__device__ __forceinline__ int map_glu(int n) { return n < 1024 ? 256 * (n >> 7) + (n & 127) : 256 * ((n - 1024) >> 7) + 128 + ((n - 1024) & 127); }
__device__ __forceinline__ int map_il(int n, int half) { return 256 * (n >> 7) + 128 * half + (n & 127); }

__device__ __forceinline__ void sincos_small(float x, float& s, float& c) {
    const float q = rintf(x * 0.63661977236758f);
    float r = fmaf(-q, 1.5707962513e+00f, x); r = fmaf(-q, 7.5497894159e-08f, r); r = fmaf(-q, 5.3903029534e-15f, r);
    const float r2 = r * r;
    const float sp = r * (1.0f + r2 * (-1.6666667163e-01f + r2 * (8.3333337680e-03f + r2 * (-1.9841270114e-04f + r2 * 2.7557314297e-06f))));
    const float cp = 1.0f + r2 * (-0.5f + r2 * (4.1666667908e-02f + r2 * (-1.3888889225e-03f + r2 * (2.4801587642e-05f + r2 * -2.7557314297e-07f))));
    const int qi = ((int)q) & 3;
    s = (qi == 0) ? sp : (qi == 1) ? cp : (qi == 2) ? -sp : -cp;
    c = (qi == 0) ? cp : (qi == 1) ? -sp : (qi == 2) ? -cp : sp;
}

__device__ __forceinline__ void s5_precompute(Ctx& F, int layer) {
    if (blockIdx.x >= 256) return;
    const int g = blockIdx.x >> 3, p = blockIdx.x & 7, tid = F.tid;
    LAS float* lam = (LAS float*)F.lds;
    LAS float* bb = lam + 33 * 64 * 2;
    LAS float* cm = bb + 64 * 16 * 2;
    LAS float* kf = cm + 16 * 64 * 2;
    const float* a_re = F.in[I_AR] + layer * 2048; const float* a_im = F.in[I_AI] + layer * 2048; const float* ldt = F.in[I_LDT] + layer * 32;
    const float* b_re = F.in[I_BR] + (size_t)layer * 32768; const float* b_im = F.in[I_BI] + (size_t)layer * 32768;
    const float* c_re = F.in[I_CR] + (size_t)layer * 32768; const float* c_im = F.in[I_CI] + (size_t)layer * 32768;
    f16* s5a = (f16*)(F.ws + WS_W + W_S5A) + (size_t)g * 256 * 512;
    f16* s5b = (f16*)(F.ws + WS_W + W_S5B) + (size_t)g * 512 * AK;
    float* lam32 = (float*)(F.ws + WS_SMALL);
    if (tid < 64) {
        const int n = tid; const float dt = expf(ldt[g]); const float ar = a_re[g * 64 + n], ai = a_im[g * 64 + n];
        const float mag = expf(ar * dt); float sn, cs; sincos_small(ai * dt, sn, cs);
        const float lr = mag * cs, li = mag * sn;
        float pr = 1.f, pi = 0.f;
        for (int mm = 0; mm <= 32; ++mm) { lam[(mm * 64 + n) * 2] = pr; lam[(mm * 64 + n) * 2 + 1] = pi; const float t = pr * lr - pi * li; pi = pr * li + pi * lr; pr = t; }
        const float den = ar * ar + ai * ai, nr = lr - 1.0f;
        const float cre = (nr * ar + li * ai) / den, cim = (li * ar - nr * ai) / den;
        for (int c = 0; c < 16; ++c) { const float br = b_re[(size_t)(g * 64 + n) * 16 + c], bi = b_im[(size_t)(g * 64 + n) * 16 + c];
            bb[(n * 16 + c) * 2] = cre * br - cim * bi; bb[(n * 16 + c) * 2 + 1] = cre * bi + cim * br; }
    } else {
        for (int idx = tid - 64; idx < 1024; idx += 448) { cm[idx * 2] = c_re[(size_t)g * 1024 + idx]; cm[idx * 2 + 1] = c_im[(size_t)g * 1024 + idx]; }
    }
    __syncthreads();
    for (int o = tid; o < 1024; o += 512) {
        const int j = o >> 8, c = (o >> 4) & 15, c2 = o & 15, lag = 4 * p + j; float val = 0.f;
        for (int n = 0; n < 64; ++n) { const float cr = cm[(c * 64 + n) * 2], ci = cm[(c * 64 + n) * 2 + 1], lr = lam[(lag * 64 + n) * 2], li = lam[(lag * 64 + n) * 2 + 1];
            const float wr = cr * lr - ci * li, wi = cr * li + ci * lr; val += wr * bb[(n * 16 + c2) * 2] - wi * bb[(n * 16 + c2) * 2 + 1]; }
        kf[o] = val * 64.0f;
    }
    __syncthreads();
    for (int idx = tid; idx < 2048; idx += 512) {
        const int j = idx >> 9, t = (idx >> 4) & 31, c = idx & 15, lag = 4 * p + j;
        if (t >= lag) { f16* dst = s5b + (size_t)(t * 16 + c) * AK + 128 + (t - lag) * 16; const LAS float* k = kf + j * 256 + c * 16;
            u32x4 w0, w1; w0.x = pkh(k[0], k[1]); w0.y = pkh(k[2], k[3]); w0.z = pkh(k[4], k[5]); w0.w = pkh(k[6], k[7]); w1.x = pkh(k[8], k[9]); w1.y = pkh(k[10], k[11]); w1.z = pkh(k[12], k[13]); w1.w = pkh(k[14], k[15]);
            *(u32x4*)dst = w0; *(u32x4*)(dst + 8) = w1; }
    }
    for (int idx = tid; idx < 2048; idx += 512) {
        const int tt = idx >> 9, c = (idx >> 5) & 15, s = idx & 31, t = 4 * p + tt;
        if (s > t) { f16* dst = s5b + (size_t)(t * 16 + c) * AK + 128 + s * 16; const u32x4 z = {0u, 0u, 0u, 0u}; *(u32x4*)dst = z; *(u32x4*)(dst + 8) = z; }
    }
    for (int idx = tid; idx < 4096; idx += 512) {
        const int tt = idx >> 10, c = (idx >> 6) & 15, n = idx & 63, t = 4 * p + tt;
        const float cr = cm[(c * 64 + n) * 2], ci = cm[(c * 64 + n) * 2 + 1], lr = lam[((t + 1) * 64 + n) * 2], li = lam[((t + 1) * 64 + n) * 2 + 1];
        f16* dst = s5b + (size_t)(t * 16 + c) * AK;
        dst[n] = (f16)((cr * lr - ci * li) * 64.0f); dst[64 + n] = (f16)(-(cr * li + ci * lr) * 64.0f);
    }
    for (int idx = tid; idx < 4096; idx += 512) {
        const int ss = idx >> 10, n = (idx >> 4) & 63, c2 = idx & 15, s = 4 * p + ss;
        const float lr = lam[((31 - s) * 64 + n) * 2], li = lam[((31 - s) * 64 + n) * 2 + 1], br = bb[(n * 16 + c2) * 2], bi = bb[(n * 16 + c2) * 2 + 1];
        s5a[(size_t)n * 512 + s * 16 + c2] = (f16)((lr * br - li * bi) * 256.0f); s5a[(size_t)(64 + n) * 512 + s * 16 + c2] = (f16)((lr * bi + li * br) * 256.0f);
    }
    for (int idx = tid; idx < 1024; idx += 512) { const int row = 128 + (idx >> 3), ch = idx & 7; const u32x4 z = {0u, 0u, 0u, 0u}; *(u32x4*)(s5a + (size_t)row * 512 + p * 64 + ch * 8) = z; }
    if (p == 0 && tid < 64) { lam32[(g * 64 + tid) * 2] = lam[(32 * 64 + tid) * 2]; lam32[(g * 64 + tid) * 2 + 1] = lam[(32 * 64 + tid) * 2 + 1]; }
    __syncthreads();
}

__device__ __forceinline__ void prologue(Ctx& F, int layer) {
    s5_precompute(F, layer);
    LAS float* scr = (LAS float*)(F.lds + F.wave * 16384);
    unsigned char* W = F.ws + WS_W;
    const float* nmix = F.in[I_NMIX] + layer * 1024; const float* nffn = F.in[I_NFFN] + layer * 1024; const float* nple = F.in[I_NPLE] + layer * 1024;
    constexpr int IT_E = 32 * 256;
    constexpr int IT_WIN = 16 * 112, IT_GLU = 8 * 64, IT_SP = 8 * 32, IT_OUT = 16 * 32, IT_PG = 16 * 32, IT_PP = 4 * 32;
    constexpr int NITEMS = 3 * IT_E + IT_WIN + IT_GLU + IT_SP + IT_OUT + IT_PG + IT_PP;
    for (int it = F.gw; it < NITEMS; it += F.NGW) {
        int r = it;
        if (r < 2 * IT_E) { const int up = r >= IT_E; if (up) r -= IT_E; const int e = r >> 8, q = r & 255, kb = q >> 4, nb = q & 15;
            const float* src = F.in[up ? I_WEU : I_WEG] + ((size_t)layer * 32 + e) * 1024 * 512;
            tr_item(src, 512, 1024, nffn, (f16*)(W + W_GU) + (size_t)e * 1024 * 1024, map_il(nb * 32, up), scr, kb * 64, nb * 32, F.lane); continue; } r -= 2 * IT_E;
        if (r < IT_E) { const int e = r >> 8, q = r & 255, kb = q >> 5, nb = q & 31;
            tr_item(F.in[I_WED] + ((size_t)layer * 32 + e) * 512 * 1024, 1024, 512, nullptr, (f16*)(W + W_D) + (size_t)e * 1024 * 512, nb * 32, scr, kb * 64, nb * 32, F.lane); continue; } r -= IT_E;
        if (r < IT_WIN) { const int kb = r / 112, nb = r % 112;
            tr_item(F.in[I_WIN] + (size_t)layer * 1024 * 3584, 3584, 1024, nmix, (f16*)(W + W_IN), map_win(nb * 32), scr, kb * 64, nb * 32, F.lane); continue; } r -= IT_WIN;
        if (r < IT_GLU) { const int kb = r >> 6, nb = r & 63;
            tr_item(F.in[I_WGLU] + (size_t)layer * 512 * 2048, 2048, 512, nullptr, (f16*)(W + W_GLU), map_glu(nb * 32), scr, kb * 64, nb * 32, F.lane); continue; } r -= IT_GLU;
        if (r < IT_SP) { const int kb = r >> 5, nb = r & 31;
            tr_item(F.in[I_WSP] + (size_t)layer * 512 * 1024, 1024, 512, nullptr, (f16*)(W + W_SP), nb * 32, scr, kb * 64, nb * 32, F.lane); continue; } r -= IT_SP;
        if (r < IT_OUT) { const int kb = r >> 5, nb = r & 31;
            tr_item(F.in[I_WOUT] + (size_t)layer * 1024 * 1024, 1024, 1024, nullptr, (f16*)(W + W_OUT), nb * 32, scr, kb * 64, nb * 32, F.lane); continue; } r -= IT_OUT;
        if (r < IT_PG) { const int kb = r >> 5, nb = r & 31;
            tr_item(F.in[I_WPG] + (size_t)layer * 1024 * 1024, 1024, 1024, nple, (f16*)(W + W_PG), nb * 32, scr, kb * 64, nb * 32, F.lane); continue; } r -= IT_PG;
        { const int kb = r >> 5, nb = r & 31;
            tr_item(F.in[I_WPP] + (size_t)layer * 256 * 1024, 1024, 256, nullptr, (f16*)(W + W_PP), nb * 32, scr, kb * 64, nb * 32, F.lane); }
    }
    const int gt = blockIdx.x * 512 + F.tid, NGT = F.G * 512;
    { const float* wre = F.in[I_WRE] + (size_t)layer * 1024 * 32; const float* wrg = F.in[I_WRG] + (size_t)layer * 1024 * 4; f16* wr16 = (f16*)(W + W_R);
      for (int i = gt; i < 48 * 1024; i += NGT) { const int n = i >> 10, k = i & 1023; const float v = n < 32 ? wre[k * 32 + n] : (n < 36 ? wrg[k * 4 + (n - 32)] : 0.f); wr16[i] = (f16)(v * nffn[k]); } }
    { const float* sw = F.in[I_SGW] + (size_t)layer * 65536; f16* wsm = (f16*)(W + W_SM);
      for (int i = gt; i < 65536; i += NGT) { const int t = (i >> 7) & 127, s = i & 127; wsm[i] = (f16)(s <= t ? sw[i] : 0.f); } }
    { const float* p = F.in[I_P] + (size_t)layer * T * 256; f16* p16 = (f16*)(F.ws + WS_P16);
      for (size_t i = (size_t)gt * 4; i < (size_t)T * 256; i += (size_t)NGT * 4) { const f32x4 v = *(const f32x4*)(p + i); u32x2 w; w.x = pkh(v[0], v[1]); w.y = pkh(v[2], v[3]); *(u32x2*)(p16 + i) = w; } }
    if (layer == 0) {
        const float* x = F.in[I_X]; f16* h16 = (f16*)(F.ws + WS_H16); float* rsm = (float*)(F.ws + WS_RSM);
        for (int row = F.gw; row < T; row += F.NGW) {
            const f32x4* xr = (const f32x4*)(x + (size_t)row * DM) + F.lane; f32x4 v[4]; float s = 0.f;
#pragma unroll
            for (int j = 0; j < 4; ++j) { v[j] = xr[64 * j]; s += (v[j][0] * v[j][0] + v[j][1] * v[j][1]) + (v[j][2] * v[j][2] + v[j][3] * v[j][3]); }
            s = wave_sum(s);
            u32x2* o = (u32x2*)(h16 + (size_t)row * DM) + F.lane;
#pragma unroll
            for (int j = 0; j < 4; ++j) { u32x2 w; w.x = pkh(v[j][0], v[j][1]); w.y = pkh(v[j][2], v[j][3]); o[64 * j] = w; }
            if (F.lane == 0) rsm[row] = 1.0f / sqrtf(s * (1.0f / DM) + EPS);
        }
    } else {
        const u64* ssq = (const u64*)(F.ws + WS_CTL + CTL_SSQ1); float* rsm = (float*)(F.ws + WS_RSM);
        for (int i = gt; i < T; i += NGT) rsm[i] = rstd_u64(ssq, i);
    }
}

__device__ __forceinline__ void sgu_phase(Ctx& F, int layer) {
    LAS f16* vt = (LAS f16*)F.lds;
    LAS float* part = (LAS float*)(F.lds + 128 * 272);
    LAS f16* rs16 = (LAS f16*)(F.lds + 128 * 272 + 2048);
    const float* nw = F.in[I_SGN] + layer * 512; const float* bs = F.in[I_SGB] + layer * 512;
    const f16* wsm = (const f16*)(F.ws + WS_W + W_SM); const f16* VT = (const f16*)(F.ws + WS_ACT + A_VT); f16* U16 = (f16*)(F.ws + WS_ACT + A_U16);
    const int tid = F.tid, fr = F.lane & 15, fq = F.lane >> 4, wave = F.wave;
    for (int it = F.vcu; it < 1024; it += F.G) {
        const int h = it & 3, tok0 = (it >> 2) * 128;
#pragma unroll
        for (int q = 0; q < 4; ++q) { const int row = (tid >> 4) + 32 * q, ch = tid & 15;
            *(LAS u32x4*)(vt + row * 136 + ch * 8) = *(const u32x4*)(VT + (size_t)(h * 128 + row) * T + tok0 + ch * 8); }
        __syncthreads();
        { const int s = tid & 127, pp = tid >> 7; float a = 0.f;
          for (int d = 0; d < 32; ++d) { const float v = (float)vt[(pp * 32 + d) * 136 + s]; a += v * v; }
          part[pp * 128 + s] = a; }
        __syncthreads();
        if (tid < 128) { const float sm = (part[tid] + part[128 + tid]) + (part[256 + tid] + part[384 + tid]); rs16[tid] = (f16)(1.0f / sqrtf(sm * (1.0f / 128.0f) + EPS)); }
        __syncthreads();
        const int t0 = 16 * wave, nk = (16 * wave + 15) / 32 + 1;
        f32x4 acc[8];
#pragma unroll
        for (int j = 0; j < 8; ++j) acc[j] = (f32x4){0.f, 0.f, 0.f, 0.f};
        for (int kk = 0; kk < nk; ++kk) {
            f16x8 a = *(const f16x8*)(wsm + (size_t)(h * 128 + t0 + fr) * 128 + 32 * kk + 8 * fq);
            const f16x8 r = *(const LAS f16x8*)(rs16 + 32 * kk + 8 * fq);
            a = a * r;
#pragma unroll
            for (int j = 0; j < 8; ++j) { const f16x8 b = *(const LAS f16x8*)(vt + (16 * j + fr) * 136 + 32 * kk + 8 * fq); acc[j] = __builtin_amdgcn_mfma_f32_16x16x32_f16(b, a, acc[j], 0, 0, 0); }
        }
        const int t = t0 + fr; const float bsv = bs[h * 128 + t]; f16* urow = U16 + (size_t)(tok0 + t) * 512 + h * 128;
#pragma unroll
        for (int j = 0; j < 8; ++j) { const int d = 16 * j + 4 * fq; const f32x4 nv = *(const f32x4*)(nw + h * 128 + d);
            const f16x4 uu = *(const f16x4*)(urow + d); u32x2 w;
            w.x = pkh((float)uu[0] * (acc[j][0] * nv[0] + bsv), (float)uu[1] * (acc[j][1] * nv[1] + bsv));
            w.y = pkh((float)uu[2] * (acc[j][2] * nv[2] + bsv), (float)uu[3] * (acc[j][3] * nv[3] + bsv));
            *(u32x2*)(urow + d) = w; }
        __syncthreads();
    }
}

__device__ __forceinline__ void s5_scan(Ctx& F) {
    const int idx = blockIdx.x * 512 + F.tid; if (idx >= 32 * 16 * 64) return;
    const int n = idx & 63, b = (idx >> 6) & 15, g = idx >> 10;
    const float* lam32 = (const float*)(F.ws + WS_SMALL); const float lr = lam32[(g * 64 + n) * 2], li = lam32[(g * 64 + n) * 2 + 1];
    const float* sst = (const float*)(F.ws + WS_SST) + (size_t)(g * 1024 + b * 64) * 128; f16* ax = (f16*)(F.ws + WS_ACT + A_AEXT) + (size_t)(g * 1024 + b * 64) * AK;
    float hr = 0.f, hi = 0.f;
    for (int k = 0; k < NCHK; ++k) {
        ax[(size_t)k * AK + n] = (f16)hr; ax[(size_t)k * AK + 64 + n] = (f16)hi;
        const float sr = sst[k * 128 + n], si = sst[k * 128 + 64 + n];
        const float t = lr * hr - li * hi + sr; hi = lr * hi + li * hr + si; hr = t;
    }
}

__device__ __forceinline__ void router_phase(Ctx& F, int layer) {
    LAS f16* wl = (LAS f16*)F.lds;
    LAS float* lg = (LAS float*)(F.lds + 100 * 1024);
    LAS int* hist = (LAS int*)(F.lds + 126 * 1024);
    const f16* wr16 = (const f16*)(F.ws + WS_W + W_R); const f16* H16 = (const f16*)(F.ws + WS_H16);
    int* cnt = (int*)(F.ws + WS_CTL) + CW_CNT + layer * 32;
    int* ldst = (int*)(F.ws + WS_LDST); float* lw = (float*)(F.ws + WS_LW); float* lrs = (float*)(F.ws + WS_LRS);
    const float* brg = F.in[I_BRG] + layer * 4; const float* bre = F.in[I_BRE] + layer * 32;
    const int tid = F.tid, lane = F.lane, fr = lane & 15, fq = lane >> 4, wave = F.wave;
    for (int q = 0; q < 12; ++q) { const int idx = tid + 512 * q, row = idx >> 7, ch = idx & 127; *(LAS u32x4*)(wl + row * 1032 + ch * 8) = *(const u32x4*)(wr16 + row * 1024 + ch * 8); }
    for (int blk = blockIdx.x; blk < T / 128; blk += F.G) {
        if (tid < 64) hist[tid] = 0;
        __syncthreads();
        const int tokbase = blk * 128 + wave * 16;
        f32x4 acc[3]; acc[0] = acc[1] = acc[2] = (f32x4){0.f, 0.f, 0.f, 0.f}; float ss = 0.f;
        const f16* arow = H16 + (size_t)(tokbase + fr) * 1024 + 8 * fq;
#pragma unroll 4
        for (int kk = 0; kk < 32; ++kk) {
            const f16x8 a = *(const f16x8*)(arow + 32 * kk);
#pragma unroll
            for (int i = 0; i < 8; ++i) { const float v = (float)a[i]; ss += v * v; }
#pragma unroll
            for (int j = 0; j < 3; ++j) { const f16x8 b = *(const LAS f16x8*)(wl + (16 * j + fr) * 1032 + 32 * kk + 8 * fq); acc[j] = __builtin_amdgcn_mfma_f32_16x16x32_f16(b, a, acc[j], 0, 0, 0); }
        }
        ss += __shfl_xor(ss, 16); ss += __shfl_xor(ss, 32);
#pragma unroll
        for (int j = 0; j < 3; ++j)
#pragma unroll
            for (int i = 0; i < 4; ++i) lg[(wave * 16 + fr) * 48 + 16 * j + 4 * fq + i] = acc[j][i];
        LDS_WAIT(); asm volatile("" ::: "memory");
        int e0 = 0, e1 = 0, pos0 = 0, pos1 = 0; float w0 = 0.f, w1 = 0.f, rstd = 0.f;
        if (lane < 16) {
            rstd = 1.0f / sqrtf(ss * (1.0f / DM) + EPS);
            const LAS float* L = lg + (wave * 16 + lane) * 48;
            float gl[4];
#pragma unroll
            for (int i = 0; i < 4; ++i) gl[i] = L[32 + i] * rstd + brg[i];
            int g = 0; float gm = gl[0];
#pragma unroll
            for (int i = 1; i < 4; ++i) if (gl[i] > gm) { gm = gl[i]; g = i; }
            float den = 0.f;
#pragma unroll
            for (int i = 0; i < 4; ++i) den += __expf(gl[i] - gm);
            const float gwt = 1.0f / den;
            float v0 = -3.0e38f, v1 = -3.0e38f; int i0 = 0, i1 = 0;
            for (int i = 0; i < 8; ++i) { const float v = L[8 * g + i] * rstd + bre[8 * g + i];
                if (v > v0) { v1 = v0; i1 = i0; v0 = v; i0 = i; } else if (v > v1) { v1 = v; i1 = i; } }
            w0 = 1.0f / (1.0f + __expf(v1 - v0)); w1 = (1.0f - w0) * gwt; w0 *= gwt;
            e0 = 8 * g + i0; e1 = 8 * g + i1;
            pos0 = __hip_atomic_fetch_add(&hist[e0], 1, __ATOMIC_RELAXED, __HIP_MEMORY_SCOPE_WORKGROUP);
            pos1 = __hip_atomic_fetch_add(&hist[e1], 1, __ATOMIC_RELAXED, __HIP_MEMORY_SCOPE_WORKGROUP);
        }
        __syncthreads();
        if (tid < 32) { const int c = hist[tid]; hist[32 + tid] = c ? (int)atomicAdd((unsigned*)(cnt + tid), (unsigned)c) : 0; }
        __syncthreads();
        if (lane < 16) {
            const int tk = tokbase + lane;
            const size_t o0 = (size_t)e0 * T + hist[32 + e0] + pos0, o1 = (size_t)e1 * T + hist[32 + e1] + pos1;
            ldst[o0] = 2 * tk; lw[o0] = w0; lrs[o0] = rstd; ldst[o1] = 2 * tk + 1; lw[o1] = w1; lrs[o1] = rstd;
        }
        __syncthreads();
    }
}

__device__ __forceinline__ void p9_phase(Ctx& F) {
    float* hb = (float*)(F.ws + WS_HB); f16* h16 = (f16*)(F.ws + WS_H16); const f16* c16 = (const f16*)(F.ws + WS_ACT + A_C16); float* rs = (float*)(F.ws + WS_RS);
    for (int row = F.gw; row < T; row += F.NGW) {
        f32x4* hr = (f32x4*)(hb + (size_t)row * DM) + F.lane; const u32x2* c0 = (const u32x2*)(c16 + (size_t)(2 * row) * DM) + F.lane; const u32x2* c1 = (const u32x2*)(c16 + (size_t)(2 * row + 1) * DM) + F.lane;
        u32x2* o = (u32x2*)(h16 + (size_t)row * DM) + F.lane; float s = 0.f;
#pragma unroll
        for (int j = 0; j < 4; ++j) { f32x4 v = hr[64 * j]; const f16x4 a = __builtin_bit_cast(f16x4, c0[64 * j]), b = __builtin_bit_cast(f16x4, c1[64 * j]);
#pragma unroll
            for (int i = 0; i < 4; ++i) { v[i] = v[i] + ((float)a[i] + (float)b[i]); s += v[i] * v[i]; }
            hr[64 * j] = v; u32x2 w; w.x = pkh(v[0], v[1]); w.y = pkh(v[2], v[3]); o[64 * j] = w; }
        s = wave_sum(s);
        if (F.lane == 0) rs[row] = 1.0f / sqrtf(s * (1.0f / DM) + EPS);
    }
}
__device__ __forceinline__ void final_phase(Ctx& F) {
    const u64* ssq = (const u64*)(F.ws + WS_CTL + CTL_SSQ2); const f32x4* gf = (const f32x4*)F.in[I_NFIN] + F.lane;
    for (int row = F.gw; row < T; row += F.NGW) {
        const float r = rstd_u64(ssq, row); f32x4* o = (f32x4*)(F.out + (size_t)row * DM) + F.lane;
#pragma unroll
        for (int j = 0; j < 4; ++j) o[64 * j] = o[64 * j] * r * gf[64 * j];
    }
}

constexpr int PH_PER_LAYER = 12, N_PHASES = 1 + 2 * PH_PER_LAYER;

__global__ void __launch_bounds__(NWAVES * 64, 2) mega_fwd(Args args) {
    extern __shared__ __attribute__((aligned(16))) unsigned char lds_raw[];
    Ctx F;
    F.lds = (LAS unsigned char*)lds_raw; F.ws = args.ws; F.in = args.in; F.out = args.out;
    F.tid = threadIdx.x; F.lane = F.tid & 63; F.wave = __builtin_amdgcn_readfirstlane(F.tid >> 6);
    F.G = gridDim.x; { const int bx = blockIdx.x; F.vcu = (F.G % 8 == 0) ? (bx % 8) * (F.G / 8) + bx / 8 : bx; }
    F.gw = F.vcu * NWAVES + F.wave; F.NGW = F.G * NWAVES;
    volatile LAS unsigned* MISC = (volatile LAS unsigned*)(F.lds + MISC_OFF);
    LAS int* tbl = (LAS int*)(F.lds + LDSX_OFF);
    for (int u = F.tid; u < (LDS_BYTES - RING_BYTES) / 4; u += NWAVES * 64) ((LAS unsigned*)(F.lds + RING_BYTES))[u] = 0u;
    __syncthreads();
    unsigned* ctl = (unsigned*)(F.ws + WS_CTL);
    XcdBarrier bar; bar.bar = ctl + CW_BAR; bar.x = 0; bar.st = nullptr;
    const int lo = args.ph_lo, hi = args.ph_hi;
    const bool use_bar = (hi - lo) > 1;
    if (use_bar) bar = xcd_barrier_post(ctl + CW_BAR, MISC + 8);
    unsigned char* W = F.ws + WS_W; unsigned char* ACT = F.ws + WS_ACT;
    float* HB = (float*)(F.ws + WS_HB); f16* H16 = (f16*)(F.ws + WS_H16);
    LAS unsigned char* ring = F.lds;

#ifndef PHMASK
#define PHMASK 0x1FFF
#endif
#define IN(k) (lo <= (k) && (k) < hi && ((PHMASK >> ((k) == 0 ? 12 : ((k) - 1) % 12)) & 1))
#define SEAM(k) do { if (use_bar && IN(k) && IN((k) + 1)) xcd_barrier(bar); } while (0)
    if (IN(0)) prologue(F, 0);
    SEAM(0);
#define LAYER_BODY(layer, base) do { \
    if (IN((base) + 0)) {              \
        const float* ssq = (const float*)(F.ws + WS_RSM); \
        { pg8::SchedStd S; S.init(T / 256, 12, F.G, (int)blockIdx.x, H16, W + W_IN, (size_t)256 * 2048, (size_t)256 * 2048); \
          EpiP1Main E{ssq, (f16*)(ACT + A_AEXT), (f16*)(ACT + A_U16), (f16*)(ACT + A_GA), (f16*)(ACT + A_GB)}; \
          pg8::gemm_phase<EpiP1Main, pg8::SchedStd, false>(ring, 16, 2048u, 2048u, S, E); } \
        __syncthreads(); \
        { pg8::SchedStd S; S.init(2, T / 256, F.G, (int)blockIdx.x, W + W_V, H16, (size_t)256 * 2048, (size_t)256 * 2048); \
          EpiP1VT E{ssq, (f16*)(ACT + A_VT)}; \
          pg8::gemm_phase<EpiP1VT, pg8::SchedStd, false>(ring, 16, 2048u, 2048u, S, E); } \
    } \
    SEAM((base) + 0); \
    if (IN((base) + 1)) {              \
        sgu_phase(F, (layer)); \
        __syncthreads(); \
        { pg8::SchedGrp S; S.nPM = 4; S.nPN = 1; S.ntot = 128; S.G = F.G; S.c = F.vcu; S.A = (const char*)(ACT + A_AEXT) + 256; S.B = (const char*)(W + W_S5A); \
          S.ga = (size_t)1024 * AK * 2; S.gb = (size_t)256 * 1024; S.ta = (size_t)256 * AK * 2; S.tb = 0; \
          EpiS5a E{(float*)(F.ws + WS_SST)}; \
          pg8::gemm_phase<EpiS5a, pg8::SchedGrp, false>(ring, 8, (unsigned)(AK * 2), 1024u, S, E); } \
    } \
    SEAM((base) + 1); \
    if (IN((base) + 2)) {              \
        s5_scan(F); \
        { pg8::SchedStd S; S.init(T / 256, 4, F.G, (int)blockIdx.x, ACT + A_U16, W + W_SP, (size_t)256 * 1024, (size_t)256 * 1024); \
          EpiP3a E{(f16*)(ACT + A_GB)}; \
          pg8::gemm_phase<EpiP3a, pg8::SchedStd, false>(ring, 8, 1024u, 1024u, S, E); } \
    } \
    SEAM((base) + 2); \
    if (IN((base) + 3)) {              \
        pg8::SchedGrp S; S.nPM = 4; S.nPN = 2; S.ntot = 256; S.G = F.G; S.c = F.vcu; S.A = (const char*)(ACT + A_AEXT); S.B = (const char*)(W + W_S5B); \
        S.ga = (size_t)1024 * AK * 2; S.gb = (size_t)512 * AK * 2; S.ta = (size_t)256 * AK * 2; S.tb = (size_t)256 * AK * 2; \
        EpiS5b E{(const f16*)(ACT + A_AEXT), F.in[I_D] + (layer) * 512, (f16*)(ACT + A_VT)}; \
        pg8::gemm_phase<EpiS5b, pg8::SchedGrp, false>(ring, 10, (unsigned)(AK * 2), (unsigned)(AK * 2), S, E); \
    } \
    SEAM((base) + 3); \
    if (IN((base) + 4)) {              \
        pg8::SchedStd S; S.init(T / 256, 8, F.G, (int)blockIdx.x, ACT + A_VT, W + W_GLU, (size_t)256 * 1024, (size_t)256 * 1024); \
        EpiP3b E{(const f16*)(ACT + A_GA), (f16*)(ACT + A_GB)}; \
        pg8::gemm_phase<EpiP3b, pg8::SchedStd, false>(ring, 8, 1024u, 1024u, S, E); \
    } \
    SEAM((base) + 4); \
    if (IN((base) + 5)) {              \
        pg8::SchedStd S; S.init(T / 256, 4, F.G, (int)blockIdx.x, ACT + A_GB, W + W_OUT, (size_t)256 * 2048, (size_t)256 * 2048); \
        EpiP4 E{(layer) == 0 ? F.in[I_X] : (const float*)HB, HB, H16}; \
        pg8::gemm_phase<EpiP4, pg8::SchedStd, false>(ring, 16, 2048u, 2048u, S, E); \
    } \
    SEAM((base) + 5); \
    if (IN((base) + 6)) router_phase(F, (layer)); \
    SEAM((base) + 6); \
    if (IN((base) + 7)) {              \
        const int* cnt = (const int*)(F.ws + WS_CTL) + CW_CNT + (layer) * 32; \
        if (F.tid == 0) { int s = 0; for (int e = 0; e < 32; ++e) { tbl[e] = s; s += (__hip_atomic_load(cnt + e, __ATOMIC_RELAXED, __HIP_MEMORY_SCOPE_AGENT) + 255) >> 8; } tbl[32] = s; } \
        __syncthreads(); \
        pg8::SchedMoE S; S.tbl = tbl; S.cnt = cnt; S.ldst = (const int*)(F.ws + WS_LDST); S.G = F.G; S.c = F.vcu; \
        S.A = (const char*)H16; S.B = (const char*)(W + W_GU); S.ta = 0; S.eb = (size_t)1024 * 2048; S.tbB = (size_t)256 * 2048; S.gather = true; \
        EpiP7 E{(const float*)(F.ws + WS_LRS), (f16*)(ACT + A_HID)}; \
        pg8::gemm_phase<EpiP7, pg8::SchedMoE, true>(ring, 16, 2048u, 2048u, S, E); \
    } \
    SEAM((base) + 7); \
    if (IN((base) + 8)) {              \
        const int* cnt = (const int*)(F.ws + WS_CTL) + CW_CNT + (layer) * 32; \
        if (F.tid == 0) { int s = 0; for (int e = 0; e < 32; ++e) { tbl[e] = s; s += (__hip_atomic_load(cnt + e, __ATOMIC_RELAXED, __HIP_MEMORY_SCOPE_AGENT) + 255) >> 8; } tbl[32] = s; } \
        __syncthreads(); \
        pg8::SchedMoE S; S.tbl = tbl; S.cnt = cnt; S.ldst = (const int*)(F.ws + WS_LDST); S.G = F.G; S.c = F.vcu; \
        S.A = (const char*)(ACT + A_HID); S.B = (const char*)(W + W_D); S.ta = (size_t)256 * 1024; S.eb = (size_t)1024 * 1024; S.tbB = (size_t)256 * 1024; S.gather = false; \
        EpiP8 E{(const int*)(F.ws + WS_LDST), (const float*)(F.ws + WS_LW), (f16*)(ACT + A_C16)}; \
        pg8::gemm_phase<EpiP8, pg8::SchedMoE, false>(ring, 8, 1024u, 1024u, S, E); \
    } \
    SEAM((base) + 8); \
    if (IN((base) + 9)) {              \
        p9_phase(F); \
        { pg8::SchedStd S; S.init(T / 256, 4, F.G, (int)blockIdx.x, F.ws + WS_P16, W + W_PP, (size_t)256 * 512, (size_t)256 * 512); \
          EpiPP E{(f16*)(ACT + A_PP)}; \
          pg8::gemm_phase<EpiPP, pg8::SchedStd, false>(ring, 4, 512u, 512u, S, E); } \
    } \
    SEAM((base) + 9); \
    if (IN((base) + 10)) {             \
        pg8::SchedStd S; S.init(T / 256, 4, F.G, (int)blockIdx.x, H16, W + W_PG, (size_t)256 * 2048, (size_t)256 * 2048); \
        EpiP10 E{(const float*)(F.ws + WS_RS), (const f16*)(ACT + A_PP), (const float*)HB, (layer) == 0 ? HB : F.out, H16, (u64*)(F.ws + WS_CTL + ((layer) == 0 ? CTL_SSQ1 : CTL_SSQ2))}; \
        pg8::gemm_phase<EpiP10, pg8::SchedStd, false>(ring, 16, 2048u, 2048u, S, E); \
    } \
    SEAM((base) + 10); \
    if (IN((base) + 11)) { if ((layer) == 0) prologue(F, 1); else final_phase(F); } \
    } while (0)
    LAYER_BODY(0, 1);
    SEAM(12);
    LAYER_BODY(1, 13);
#undef IN
#undef SEAM
#undef LAYER_BODY
}

extern "C" void kernel_launch(void* const* d_in, const int* in_sizes, int n_in, void* d_out, int out_size, void* d_ws, size_t ws_size, hipStream_t stream) {
    static int grid = 0;
    if (grid == 0) {
        if (n_in != 30 || out_size != T * DM || ws_size < WS_END) { fprintf(stderr, "kernel_launch: unexpected shapes (n_in %d, out %d, ws %zu < %zu)\n", n_in, out_size, ws_size, (size_t)WS_END); grid = -1; return; }
        int dev = 0, cus = 0;
        if (hipGetDevice(&dev) != hipSuccess || hipDeviceGetAttribute(&cus, hipDeviceAttributeMultiprocessorCount, dev) != hipSuccess) { grid = -1; return; }
        if (hipFuncSetAttribute((const void*)mega_fwd, hipFuncAttributeMaxDynamicSharedMemorySize, LDS_BYTES) != hipSuccess) { fprintf(stderr, "kernel_launch: hipFuncSetAttribute failed\n"); grid = -1; return; }
        int per_cu = 0;
        if (hipOccupancyMaxActiveBlocksPerMultiprocessor(&per_cu, (const void*)mega_fwd, NWAVES * 64, LDS_BYTES) != hipSuccess || per_cu < 1) fprintf(stderr, "kernel_launch: occupancy query reports %d\n", per_cu);
        (void)hipGetLastError();
        grid = cus;
    }
    if (grid < 0) return;
    if (hipMemsetAsync((char*)d_ws + WS_CTL, 0, CTL_ZERO_BYTES, stream) != hipSuccess) return;
    Args a{};
    for (int i = 0; i < 30; ++i) a.in[i] = (const float*)d_in[i];
    a.out = (float*)d_out; a.ws = (unsigned char*)d_ws;
#if MK_ONE_LAUNCH
    a.ph_lo = 0; a.ph_hi = N_PHASES;
    hipLaunchKernelGGL(mega_fwd, dim3(grid), dim3(NWAVES * 64), LDS_BYTES, stream, a);
#else
    for (int ph = 0; ph < N_PHASES; ++ph) { a.ph_lo = ph; a.ph_hi = ph + 1; hipLaunchKernelGGL(mega_fwd, dim3(grid), dim3(NWAVES * 64), LDS_BYTES, stream, a); }
#endif
}
```

```cpp
#include <hip/hip_runtime.h>
#include <cstdio>

#ifndef MK_ONE_LAUNCH
#define MK_ONE_LAUNCH 1
#endif

#define LAS __attribute__((address_space(3)))
#define GAS __attribute__((address_space(1)))
typedef _Float16 f16;
typedef _Float16 f16x2 __attribute__((ext_vector_type(2)));
typedef _Float16 f16x4 __attribute__((ext_vector_type(4)));
typedef _Float16 f16x8 __attribute__((ext_vector_type(8)));
typedef float f32x2 __attribute__((ext_vector_type(2)));
typedef float f32x4 __attribute__((ext_vector_type(4)));
typedef unsigned u32x2 __attribute__((ext_vector_type(2)));
typedef unsigned u32x4 __attribute__((ext_vector_type(4)));
typedef unsigned long long u64;
typedef GAS unsigned gu32;

constexpr int BATCH = 16, SEQ = 2048, DM = 1024, T = BATCH * SEQ;
constexpr int CHK = 32, NCHK = SEQ / CHK;
constexpr int AK = 640;
constexpr float EPS = 1e-6f;
constexpr int NWAVES = 8;
constexpr float SSQ_SCALE = 16777216.0f;

constexpr size_t MiB = 1u << 20;
constexpr size_t WS_CTL = 0, CTL_ZERO_BYTES = 2 * MiB;
constexpr size_t WS_W = 2 * MiB;
constexpr size_t W_IN = 0, W_V = 6 * MiB, W_GLU = 7 * MiB, W_SP = 9 * MiB, W_OUT = 10 * MiB, W_PG = 12 * MiB, W_PP = 14 * MiB,
                 W_R = 14 * MiB + 512 * 1024, W_SM = 14 * MiB + 768 * 1024, W_S5A = 15 * MiB, W_S5B = 23 * MiB, W_GU = 43 * MiB, W_D = 107 * MiB;
constexpr size_t WS_SMALL = 141 * MiB;
constexpr size_t WS_HB = 142 * MiB;
constexpr size_t WS_H16 = 270 * MiB;
constexpr size_t WS_P16 = 334 * MiB;
constexpr size_t WS_RS = 350 * MiB;
constexpr size_t WS_RSM = 350 * MiB + 512 * 1024;
constexpr size_t WS_LDST = 351 * MiB, WS_LW = 355 * MiB, WS_LRS = 359 * MiB;
constexpr size_t WS_SST = 363 * MiB;
constexpr size_t WS_ACT = 379 * MiB;
constexpr size_t A_AEXT = 0, A_U16 = 40 * MiB, A_VT = 72 * MiB, A_GA = 104 * MiB, A_GB = 168 * MiB;
constexpr size_t A_HID = 0, A_C16 = 72 * MiB, A_PP = 0;
constexpr size_t WS_END = 379 * MiB + 232 * MiB;
constexpr int CW_BAR = 4096;
constexpr int CW_CNT = 8192;
constexpr size_t CTL_SSQ0 = 256 * 1024, CTL_SSQ1 = 512 * 1024, CTL_SSQ2 = 768 * 1024;

constexpr int RING_BYTES = 131072;
constexpr int LDSX_OFF = RING_BYTES;
constexpr int MISC_OFF = RING_BYTES + 1024;
constexpr int LDS_BYTES = 147456;

#define LDS_WAIT() asm volatile("s_waitcnt lgkmcnt(0)" ::: "memory")
#define VM_WAIT() asm volatile("s_waitcnt vmcnt(0)" ::: "memory")
__device__ __forceinline__ float fexp2(float x) { return __builtin_amdgcn_exp2f(x); }
__device__ __forceinline__ float frcp(float x) { return __builtin_amdgcn_rcpf(x); }
__device__ __forceinline__ float sigm(float x) { return frcp(1.0f + fexp2(-1.4426950409f * x)); }
__device__ __forceinline__ float gelu_t(float x) { const float u = x + 0.044715f * x * x * x; return x * frcp(1.0f + fexp2(-2.3022082f * u)); }
__device__ __forceinline__ float silu_f(float x) { return x * sigm(x); }
__device__ __forceinline__ unsigned pkh(float a, float b) { f16x2 v; v.x = (f16)a; v.y = (f16)b; return __builtin_bit_cast(unsigned, v); }
__device__ __forceinline__ u32x4 pk8(const f32x4 a, const f32x4 b) { u32x4 w; w.x = pkh(a[0], a[1]); w.y = pkh(a[2], a[3]); w.z = pkh(b[0], b[1]); w.w = pkh(b[2], b[3]); return w; }
__device__ __forceinline__ void unpk8(const u32x4 w, f32x4& a, f32x4& b) {
    const f16x8 h = __builtin_bit_cast(f16x8, w);
    a = (f32x4){(float)h[0], (float)h[1], (float)h[2], (float)h[3]}; b = (f32x4){(float)h[4], (float)h[5], (float)h[6], (float)h[7]};
}
__device__ __forceinline__ float wave_sum(float v) {
#pragma unroll
    for (int o = 1; o < 64; o <<= 1) v += __shfl_xor(v, o);
    return v;
}
__device__ __forceinline__ float rstd_u64(const u64* p, int row) { const float s = (float)p[row] * (1.0f / SSQ_SCALE); return 1.0f / sqrtf(s * (1.0f / DM) + EPS); }

namespace pg8 {
constexpr int BM = 256, BK = 64, HALF = 128, HTB = HALF * BK * 2, STAGE_BYTES = 8 * HTB, NXCD = 8, WGM = 8;
__device__ __forceinline__ int lds_byte(int r, int c) { const int st = (r >> 4) * 2 + (c >> 5), rr = r & 15, cc = c & 31, ob = rr * 64 + cc * 2; return st * 1024 + (ob ^ (((ob >> 9) & 1) << 5)); }
__device__ __forceinline__ void stage_rc(int b, int& R, int& C) { const int st = b / 1024, sb = b % 1024, swz = sb ^ (((sb >> 9) & 1) << 5); R = (st >> 1) * 16 + swz / 64; C = (st & 1) * 32 + (swz % 64) / 2; }
__device__ __forceinline__ int perm32(int rho) { const int n = rho >> 4, i = rho & 15; return 8 * (i >> 2) + 4 * n + (i & 3); }

struct Unit { int pm, pn, g, aux, mt; };

struct SchedStd {
    int nM, nN, nwg, G, c; const char* A; const char* B; size_t ta, tb;
    __device__ __forceinline__ void init(int nM_, int nN_, int G_, int c_, const void* A_, const void* B_, size_t ta_, size_t tb_) { nM = nM_; nN = nN_; nwg = nM * nN; G = G_; c = c_; A = (const char*)A_; B = (const char*)B_; ta = ta_; tb = tb_; }
    __device__ __forceinline__ bool next(int i, Unit& u) const {
        const long L = (long)i * G + c; if (L >= nwg) return false;
        int wgid = (int)L; { const int q = nwg / NXCD, r = nwg % NXCD, xcd = wgid % NXCD, off = wgid / NXCD; wgid = (xcd < r ? xcd * (q + 1) : r * (q + 1) + (xcd - r) * q) + off; }
        const int nig = WGM * nN, gid = wgid / nig, fm = gid * WGM, gsz = (nM - fm) < WGM ? (nM - fm) : WGM;
        u.pm = fm + ((wgid % nig) % gsz); u.pn = (wgid % nig) / gsz; u.g = 0; u.aux = 0; u.mt = 0; return true;
    }
    __device__ __forceinline__ const char* a_ptr(const Unit& u) const { return A + (size_t)u.pm * ta; }
    __device__ __forceinline__ const char* b_ptr(const Unit& u) const { return B + (size_t)u.pn * tb; }
    __device__ __forceinline__ unsigned a_row(const Unit&, int) const { return 0u; }
};
struct SchedGrp {
    int nPM, nPN, ntot, G, c; const char* A; const char* B; size_t ga, gb, ta, tb;
    __device__ __forceinline__ bool next(int i, Unit& u) const {
        const int L = i * G + c; if (L >= ntot) return false;
        const int per = nPM * nPN; u.g = L / per; const int r = L % per; u.pn = r / nPM; u.pm = r % nPM; u.aux = 0; u.mt = 0; return true;
    }
    __device__ __forceinline__ const char* a_ptr(const Unit& u) const { return A + (size_t)u.g * ga + (size_t)u.pm * ta; }
    __device__ __forceinline__ const char* b_ptr(const Unit& u) const { return B + (size_t)u.g * gb + (size_t)u.pn * tb; }
    __device__ __forceinline__ unsigned a_row(const Unit&, int) const { return 0u; }
};
struct SchedMoE {
    const LAS int* tbl; const int* cnt; const int* ldst; int G, c; const char* A; const char* B; size_t ta, eb, tbB; bool gather;
    __device__ __forceinline__ bool next(int i, Unit& u) const {
        const int L = i * G + c; const int mt = L >> 2; const int tot = __builtin_amdgcn_readfirstlane(tbl[32]);
        if (mt >= tot) return false;
        int e = 0;
        for (int k = 1; k < 32; ++k) { const int s = __builtin_amdgcn_readfirstlane(tbl[k]); if (mt >= s) e = k; }
        u.g = e; u.pm = mt - __builtin_amdgcn_readfirstlane(tbl[e]); u.pn = L & 3; u.aux = __builtin_amdgcn_readfirstlane(cnt[e]); u.mt = mt; return true;
    }
    __device__ __forceinline__ const char* a_ptr(const Unit& u) const { return gather ? A : A + (size_t)u.mt * ta; }
    __device__ __forceinline__ const char* b_ptr(const Unit& u) const { return B + (size_t)u.g * eb + (size_t)u.pn * tbB; }
    __device__ __forceinline__ unsigned a_row(const Unit& u, int r) const { const int pos = u.pm * 256 + r; return pos < u.aux ? (unsigned)(ldst[(size_t)u.g * T + pos] >> 1) : 0u; }
};

template <class Epi, class Sched, bool GATHER>
__device__ __forceinline__ void gemm_phase(LAS unsigned char* lds, const int nt, const unsigned lda, const unsigned ldb, const Sched& S, const Epi& E) {
    const int tid = threadIdx.x, wid = __builtin_amdgcn_readfirstlane(tid >> 6), lane = tid & 63, wr = wid >> 2, wc = wid & 3, fr = lane & 15, fq = lane >> 4;
    unsigned voffB[2], ccA[2]; int rA[2];
#pragma unroll
    for (int i = 0; i < 2; ++i) { int R, C; stage_rc(tid * 16 + i * 8192, R, C); const int Rb = (R & ~31) + perm32(R & 31);
        voffB[i] = (unsigned)Rb * ldb + (unsigned)C * 2u; rA[i] = R; ccA[i] = (unsigned)C * 2u; }
    const size_t kstep = (size_t)(BK * 2);
    const size_t hstepB = (size_t)HALF * ldb;
    const unsigned ldsw = (unsigned)wid * 1024u;
    const int aoff = lds_byte(wr * 64 + fr, fq * 8), boff = lds_byte(wc * 32 + fr, fq * 8);
#define PG8_SA(b, h) (((b) * 2 + (h)) * HTB)
#define PG8_SB(b, h) ((4 + (b) * 2 + (h)) * HTB)
#define PG8_STAGE_B(bufoff, gbase) do { _Pragma("unroll") for (int _i = 0; _i < 2; ++_i) \
        __builtin_amdgcn_global_load_lds((const unsigned*)((const char*)(gbase) + voffB[_i]), (LAS unsigned*)(lds + (bufoff) + ldsw + _i * 8192), 16, 0, 0); } while (0)
#define PG8_STAGE_A(bufoff, gbase, o0, o1) do { \
        __builtin_amdgcn_global_load_lds((const unsigned*)((const char*)(gbase) + (o0)), (LAS unsigned*)(lds + (bufoff) + ldsw), 16, 0, 0); \
        __builtin_amdgcn_global_load_lds((const unsigned*)((const char*)(gbase) + (o1)), (LAS unsigned*)(lds + (bufoff) + ldsw + 8192), 16, 0, 0); } while (0)
#define PG8_LDA(dst, b, h) do { _Pragma("unroll") for (int m = 0; m < 4; ++m) _Pragma("unroll") for (int k = 0; k < 2; ++k) dst[m][k] = *(const LAS f16x8*)(lds + PG8_SA(b, h) + aoff + m * 2048 + k * 1024); } while (0)
#define PG8_LDB(dst, b, h) do { _Pragma("unroll") for (int n = 0; n < 2; ++n) _Pragma("unroll") for (int k = 0; k < 2; ++k) dst[n][k] = *(const LAS f16x8*)(lds + PG8_SB(b, h) + boff + n * 2048 + k * 1024); } while (0)
#define PG8_MMA(ai, bj, At, Bt) do { __builtin_amdgcn_s_setprio(1); _Pragma("unroll") for (int m = 0; m < 4; ++m) _Pragma("unroll") for (int n = 0; n < 2; ++n) _Pragma("unroll") for (int k = 0; k < 2; ++k) \
        acc[ai][bj][m][n] = __builtin_amdgcn_mfma_f32_16x16x32_f16(Bt[n][k], At[m][k], acc[ai][bj][m][n], 0, 0, 0); __builtin_amdgcn_s_setprio(0); } while (0)
#define PG8_WAIT_V(n) asm volatile("s_waitcnt vmcnt(" #n ")" ::: "memory")
#define PG8_WAIT_L(n) asm volatile("s_waitcnt lgkmcnt(" #n ")" ::: "memory")
#define PG8_BAR __builtin_amdgcn_s_barrier()
#define PG8_SCHED __builtin_amdgcn_sched_barrier(0)
#define PG8_SETOFF(o, u) do { _Pragma("unroll") for (int _h = 0; _h < 2; ++_h) _Pragma("unroll") for (int _i = 0; _i < 2; ++_i) \
        o[_h][_i] = (GATHER ? S.a_row(u, rA[_i] + 128 * _h) : (unsigned)(rA[_i] + 128 * _h)) * lda + ccA[_i]; } while (0)
    Unit cur, nxt; int ui = 0;
    if (!S.next(0, cur)) return;
    f32x4 acc[2][2][4][2];
#pragma unroll
    for (int a = 0; a < 2; ++a)
#pragma unroll
        for (int b = 0; b < 2; ++b)
#pragma unroll
            for (int m = 0; m < 4; ++m)
#pragma unroll
                for (int n = 0; n < 2; ++n) acc[a][b][m][n] = (f32x4){0.f, 0.f, 0.f, 0.f};
    f16x8 At[4][2], B0[2][2], B1[2][2];
    unsigned oC[2][2], oN[2][2];
    PG8_SETOFF(oC, cur);
    const char* cA = S.a_ptr(cur); const char* cB = S.b_ptr(cur);
    PG8_STAGE_B(PG8_SB(0, 0), cB); PG8_STAGE_B(PG8_SB(0, 1), cB + hstepB); PG8_STAGE_A(PG8_SA(0, 0), cA, oC[0][0], oC[0][1]); PG8_STAGE_A(PG8_SA(0, 1), cA, oC[1][0], oC[1][1]);
    if (wr == 1) PG8_BAR;
    PG8_WAIT_V(2); PG8_BAR;
    PG8_STAGE_B(PG8_SB(1, 0), cB + kstep); PG8_STAGE_A(PG8_SA(1, 0), cA + kstep, oC[0][0], oC[0][1]); PG8_STAGE_B(PG8_SB(1, 1), cB + hstepB + kstep);
    PG8_WAIT_V(6); PG8_BAR;
    for (;;) {
        const bool has_next = S.next(ui + 1, nxt);
        const char* nA = has_next ? S.a_ptr(nxt) : cA; const char* nB = has_next ? S.b_ptr(nxt) : cB;
        if (GATHER) { if (has_next) { PG8_SETOFF(oN, nxt); } else {
#pragma unroll
            for (int _h = 0; _h < 2; ++_h)
#pragma unroll
                for (int _i = 0; _i < 2; ++_i) oN[_h][_i] = oC[_h][_i]; } }
#pragma clang loop unroll(disable)
        for (int t = 0; t < nt; t += 2) {
            const bool last = (t == nt - 2);
            const char* a1 = cA + (size_t)(t + 1) * kstep;
            const char* a2 = last ? nA : cA + (size_t)(t + 2) * kstep; const char* b2 = last ? nB : cB + (size_t)(t + 2) * kstep;
            const char* a3 = a2 + kstep; const char* b3 = b2 + kstep;
            unsigned x00 = oC[0][0], x01 = oC[0][1], x10 = oC[1][0], x11 = oC[1][1];
            if (GATHER) { x00 = last ? oN[0][0] : x00; x01 = last ? oN[0][1] : x01; x10 = last ? oN[1][0] : x10; x11 = last ? oN[1][1] : x11; }
            PG8_LDB(B0, 0, 0); PG8_LDB(B1, 0, 1); PG8_SCHED; PG8_LDA(At, 0, 0); PG8_STAGE_A(PG8_SA(1, 1), a1, oC[1][0], oC[1][1]);
            PG8_WAIT_V(8); PG8_WAIT_L(0); PG8_BAR; PG8_MMA(0, 0, At, B0); PG8_MMA(0, 1, At, B1); PG8_BAR; PG8_SCHED;
            PG8_LDA(At, 0, 1); PG8_STAGE_B(PG8_SB(0, 0), b2); PG8_STAGE_B(PG8_SB(0, 1), b2 + hstepB); PG8_STAGE_A(PG8_SA(0, 0), a2, x00, x01);
            PG8_WAIT_V(8); PG8_WAIT_L(0); PG8_BAR; PG8_MMA(1, 0, At, B0); PG8_MMA(1, 1, At, B1); PG8_BAR; PG8_SCHED;
            PG8_LDB(B0, 1, 0); PG8_LDB(B1, 1, 1); PG8_SCHED; PG8_LDA(At, 1, 0); PG8_STAGE_A(PG8_SA(0, 1), a2, x10, x11);
            PG8_WAIT_V(8); PG8_WAIT_L(0); PG8_BAR; PG8_MMA(0, 0, At, B0); PG8_MMA(0, 1, At, B1); PG8_BAR; PG8_SCHED;
            PG8_LDA(At, 1, 1); PG8_STAGE_B(PG8_SB(1, 0), b3); PG8_STAGE_B(PG8_SB(1, 1), b3 + hstepB); PG8_STAGE_A(PG8_SA(1, 0), a3, x00, x01);
            PG8_WAIT_V(8); PG8_WAIT_L(0); PG8_BAR; PG8_MMA(1, 0, At, B0); PG8_MMA(1, 1, At, B1); PG8_BAR; PG8_SCHED;
        }
        if (wr == 0) PG8_BAR;
        E(acc, cur, wr, wc, fr, fq);
        if (!has_next) break;
#pragma unroll
        for (int a = 0; a < 2; ++a)
#pragma unroll
            for (int b = 0; b < 2; ++b)
#pragma unroll
                for (int m = 0; m < 4; ++m)
#pragma unroll
                    for (int n = 0; n < 2; ++n) acc[a][b][m][n] = (f32x4){0.f, 0.f, 0.f, 0.f};
        cur = nxt; cA = nA; cB = nB; ++ui;
        if (GATHER) {
#pragma unroll
            for (int _h = 0; _h < 2; ++_h)
#pragma unroll
                for (int _i = 0; _i < 2; ++_i) oC[_h][_i] = oN[_h][_i]; }
        if (wr == 1) PG8_BAR;
    }
    PG8_WAIT_V(0);
    PG8_BAR;
#undef PG8_SA
#undef PG8_SB
#undef PG8_STAGE_A
#undef PG8_STAGE_B
#undef PG8_LDA
#undef PG8_LDB
#undef PG8_MMA
#undef PG8_WAIT_V
#undef PG8_WAIT_L
#undef PG8_BAR
#undef PG8_SCHED
#undef PG8_SETOFF
}
}
using pg8::Unit;
typedef f32x4 AccT[2][2][4][2];

#define EPI_ROWS_BEGIN _Pragma("unroll") for (int ai = 0; ai < 2; ++ai) _Pragma("unroll") for (int m = 0; m < 4; ++m) { int rt_ = 128 * ai + 64 * wr + 16 * m + fr; asm volatile("" : "+v"(rt_)); const int rt = rt_;
#define EPI_ROWS_END asm volatile("" ::: "memory"); }

struct EpiP1Main {
    const float* rsm; f16* aext; f16* u16; f16* ga; f16* gb;
    __device__ __forceinline__ void operator()(const AccT& acc, const Unit& u, int wr, int wc, int fr, int fq) const {
        const int pn = u.pn;
        EPI_ROWS_BEGIN
            const int tk = u.pm * 256 + rt; const float rs = rsm[tk];
#pragma unroll
            for (int bj = 0; bj < 2; ++bj) {
                const int c = 128 * bj + 32 * wc + 8 * fq; f32x4 v0 = acc[ai][bj][m][0] * rs, v1 = acc[ai][bj][m][1] * rs;
                if (pn < 2) {
                    const int cg = pn * 256 + c, g = cg >> 4, ch0 = cg & 15, b = tk >> 11, l = tk & 2047, k = l >> 5, tl = l & 31;
                    *(u32x4*)(aext + ((size_t)(g * 1024 + b * 64 + k) * AK + 128 + tl * 16 + ch0)) = pk8(v0, v1);
                } else if (pn < 4) {
#pragma unroll
                    for (int j = 0; j < 4; ++j) { v0[j] = gelu_t(v0[j]); v1[j] = gelu_t(v1[j]); }
                    *(u32x4*)(u16 + (size_t)tk * 512 + (pn - 2) * 256 + c) = pk8(v0, v1);
                } else {
#pragma unroll
                    for (int j = 0; j < 4; ++j) { v0[j] = sigm(v0[j]); v1[j] = sigm(v1[j]); }
                    f16* dst = (pn < 8) ? ga + (size_t)tk * 1024 + (pn - 4) * 256 + c : gb + (size_t)tk * 1024 + (pn - 8) * 256 + c;
                    *(u32x4*)dst = pk8(v0, v1);
                }
            }
        EPI_ROWS_END
    }
};
struct EpiP1VT {
    const float* rsm; f16* vt;
    __device__ __forceinline__ void operator()(const AccT& acc, const Unit& u, int wr, int wc, int fr, int fq) const {
        EPI_ROWS_BEGIN
            const int row = u.pm * 256 + rt;
#pragma unroll
            for (int bj = 0; bj < 2; ++bj) {
                const f32x4 r0 = *(const f32x4*)(rsm + u.pn * 256 + 128 * bj + 32 * wc + 8 * fq), r1 = *(const f32x4*)(rsm + u.pn * 256 + 128 * bj + 32 * wc + 8 * fq + 4);
                f32x4 v0 = acc[ai][bj][m][0] * r0, v1 = acc[ai][bj][m][1] * r1;
#pragma unroll
                for (int j = 0; j < 4; ++j) { v0[j] = gelu_t(v0[j]); v1[j] = gelu_t(v1[j]); }
                *(u32x4*)(vt + (size_t)row * T + u.pn * 256 + 128 * bj + 32 * wc + 8 * fq) = pk8(v0, v1);
            }
        EPI_ROWS_END
    }
};
struct EpiS5a {
    float* sst;
    __device__ __forceinline__ void operator()(const AccT& acc, const Unit& u, int wr, int wc, int fr, int fq) const {
        EPI_ROWS_BEGIN
            float* dst = sst + ((size_t)(u.g * 1024 + u.pm * 256 + rt) * 128 + 32 * wc + 8 * fq);
            *(f32x4*)dst = acc[ai][0][m][0] * (1.0f / 256.0f); *(f32x4*)(dst + 4) = acc[ai][0][m][1] * (1.0f / 256.0f);
        EPI_ROWS_END
    }
};
struct EpiS5b {
    const f16* aext; const float* dsk; f16* y16;
    __device__ __forceinline__ void operator()(const AccT& acc, const Unit& u, int wr, int wc, int fr, int fq) const {
        EPI_ROWS_BEGIN
            const int R = u.pm * 256 + rt, b = R >> 6, k = R & 63;
#pragma unroll
            for (int bj = 0; bj < 2; ++bj) {
                const int col = u.pn * 256 + 128 * bj + 32 * wc + 8 * fq, tl = col >> 4, ch0 = col & 15;
                f32x4 x0, x1; unpk8(*(const u32x4*)(aext + ((size_t)(u.g * 1024 + R) * AK + 128 + col)), x0, x1);
                const f32x4 d0 = *(const f32x4*)(dsk + u.g * 16 + ch0), d1 = *(const f32x4*)(dsk + u.g * 16 + ch0 + 4);
                f32x4 v0 = acc[ai][bj][m][0] * (1.0f / 64.0f) + d0 * x0, v1 = acc[ai][bj][m][1] * (1.0f / 64.0f) + d1 * x1;
#pragma unroll
                for (int j = 0; j < 4; ++j) { v0[j] = gelu_t(v0[j]); v1[j] = gelu_t(v1[j]); }
                *(u32x4*)(y16 + ((size_t)(b * 2048 + k * 32 + tl) * 512 + u.g * 16 + ch0)) = pk8(v0, v1);
            }
        EPI_ROWS_END
    }
};
struct EpiP3a {
    f16* gb;
    __device__ __forceinline__ void operator()(const AccT& acc, const Unit& u, int wr, int wc, int fr, int fq) const {
        EPI_ROWS_BEGIN
            const int tk = u.pm * 256 + rt;
#pragma unroll
            for (int bj = 0; bj < 2; ++bj) {
                f16* p = gb + (size_t)tk * 1024 + u.pn * 256 + 128 * bj + 32 * wc + 8 * fq;
                f32x4 g0, g1; unpk8(*(const u32x4*)p, g0, g1);
                *(u32x4*)p = pk8(g0 * acc[ai][bj][m][0], g1 * acc[ai][bj][m][1]);
            }
        EPI_ROWS_END
    }
};
struct EpiP3b {
    const f16* ga; f16* gb;
    __device__ __forceinline__ void operator()(const AccT& acc, const Unit& u, int wr, int wc, int fr, int fq) const {
        EPI_ROWS_BEGIN
            const int tk = u.pm * 256 + rt; const size_t off = (size_t)tk * 1024 + u.pn * 128 + 32 * wc + 8 * fq;
            f32x4 a0, a1, t0, t1; unpk8(*(const u32x4*)(ga + off), a0, a1); unpk8(*(const u32x4*)(gb + off), t0, t1);
            f32x4 v0 = acc[ai][0][m][0], v1 = acc[ai][0][m][1]; const f32x4 z0 = acc[ai][1][m][0], z1 = acc[ai][1][m][1];
#pragma unroll
            for (int j = 0; j < 4; ++j) { v0[j] = a0[j] * (v0[j] * sigm(z0[j])) + t0[j]; v1[j] = a1[j] * (v1[j] * sigm(z1[j])) + t1[j]; }
            *(u32x4*)(gb + off) = pk8(v0, v1);
        EPI_ROWS_END
    }
};
struct EpiP4 {
    const float* hin; float* hb; f16* h16;
    __device__ __forceinline__ void operator()(const AccT& acc, const Unit& u, int wr, int wc, int fr, int fq) const {
        EPI_ROWS_BEGIN
            const int tk = u.pm * 256 + rt;
#pragma unroll
            for (int bj = 0; bj < 2; ++bj) {
                const size_t off = (size_t)tk * 1024 + u.pn * 256 + 128 * bj + 32 * wc + 8 * fq;
                const f32x4 v0 = *(const f32x4*)(hin + off) + acc[ai][bj][m][0], v1 = *(const f32x4*)(hin + off + 4) + acc[ai][bj][m][1];
                *(f32x4*)(hb + off) = v0; *(f32x4*)(hb + off + 4) = v1; *(u32x4*)(h16 + off) = pk8(v0, v1);
            }
        EPI_ROWS_END
    }
};
struct EpiP7 {
    const float* lrs; f16* hid;
    __device__ __forceinline__ void operator()(const AccT& acc, const Unit& u, int wr, int wc, int fr, int fq) const {
        EPI_ROWS_BEGIN
            const int pos = u.pm * 256 + rt;
            if (pos < u.aux) {
                const float rs = lrs[(size_t)u.g * T + pos];
                f32x4 g0 = acc[ai][0][m][0] * rs, g1 = acc[ai][0][m][1] * rs; const f32x4 p0 = acc[ai][1][m][0] * rs, p1 = acc[ai][1][m][1] * rs;
#pragma unroll
                for (int j = 0; j < 4; ++j) { g0[j] = silu_f(g0[j]) * p0[j]; g1[j] = silu_f(g1[j]) * p1[j]; }
                *(u32x4*)(hid + ((size_t)(u.mt * 256 + rt) * 512 + u.pn * 128 + 32 * wc + 8 * fq)) = pk8(g0, g1);
            }
        EPI_ROWS_END
    }
};
struct EpiP8 {
    const int* ldst; const float* lw; f16* c16;
    __device__ __forceinline__ void operator()(const AccT& acc, const Unit& u, int wr, int wc, int fr, int fq) const {
        EPI_ROWS_BEGIN
            const int pos = u.pm * 256 + rt;
            if (pos < u.aux) {
                const int dst = ldst[(size_t)u.g * T + pos]; const float w = lw[(size_t)u.g * T + pos];
#pragma unroll
                for (int bj = 0; bj < 2; ++bj)
                    *(u32x4*)(c16 + ((size_t)dst * 1024 + u.pn * 256 + 128 * bj + 32 * wc + 8 * fq)) = pk8(acc[ai][bj][m][0] * w, acc[ai][bj][m][1] * w);
            }
        EPI_ROWS_END
    }
};
struct EpiPP {
    f16* pp;
    __device__ __forceinline__ void operator()(const AccT& acc, const Unit& u, int wr, int wc, int fr, int fq) const {
        EPI_ROWS_BEGIN
            const int tk = u.pm * 256 + rt;
#pragma unroll
            for (int bj = 0; bj < 2; ++bj)
                *(u32x4*)(pp + ((size_t)tk * 1024 + u.pn * 256 + 128 * bj + 32 * wc + 8 * fq)) = pk8(acc[ai][bj][m][0], acc[ai][bj][m][1]);
        EPI_ROWS_END
    }
};
struct EpiP10 {
    const float* rsple; const f16* pp; const float* hin; float* hout; f16* h16; u64* ssq;
    __device__ __forceinline__ void operator()(const AccT& acc, const Unit& u, int wr, int wc, int fr, int fq) const {
        EPI_ROWS_BEGIN
            const int tk = u.pm * 256 + rt; const float rs = rsple[tk]; float sq = 0.f;
#pragma unroll
            for (int bj = 0; bj < 2; ++bj) {
                const size_t off = (size_t)tk * 1024 + u.pn * 256 + 128 * bj + 32 * wc + 8 * fq;
                f32x4 p0, p1; unpk8(*(const u32x4*)(pp + off), p0, p1);
                f32x4 v0 = *(const f32x4*)(hin + off), v1 = *(const f32x4*)(hin + off + 4);
                const f32x4 a0 = acc[ai][bj][m][0] * rs, a1 = acc[ai][bj][m][1] * rs;
#pragma unroll
                for (int j = 0; j < 4; ++j) { v0[j] += p0[j] * sigm(a0[j]); v1[j] += p1[j] * sigm(a1[j]); sq += v0[j] * v0[j] + v1[j] * v1[j]; }
                *(f32x4*)(hout + off) = v0; *(f32x4*)(hout + off + 4) = v1; *(u32x4*)(h16 + off) = pk8(v0, v1);
            }
            sq += __shfl_xor(sq, 16); sq += __shfl_xor(sq, 32);
            if (fq == 0) atomicAdd(ssq + tk, (u64)(sq * SSQ_SCALE));
        EPI_ROWS_END
    }
};

#define XB_TMO      128
#define XB_XCNT(j)  (256  + 64 * (j))
#define XB_XSUB(j)  (1280 + 64 * (j))
#define XB_XGEN(j)  (2304 + 64 * (j))
#define XB_TOP      3328
#define XB_TOPGEN   3392
#define XCD_BAR_WORDS 3456
#define XB_SPIN_CAP (1u << 18)
__device__ __forceinline__ unsigned xb_ld(unsigned* p)              { return __hip_atomic_load(p, __ATOMIC_RELAXED, __HIP_MEMORY_SCOPE_AGENT); }
__device__ __forceinline__ unsigned xb_add(unsigned* p, unsigned v) { return __hip_atomic_fetch_add(p, v, __ATOMIC_RELAXED, __HIP_MEMORY_SCOPE_AGENT); }
__device__ __forceinline__ unsigned xb_xcc_id() { return (unsigned)__builtin_amdgcn_s_getreg((3 << 11) | 20) & 0xFu; }
#define XB_SPIN(cond, bar) do { unsigned _sp = 0; while (cond) { __builtin_amdgcn_s_sleep(1); \
    if ((++_sp & 255u) == 0u) { if (xb_ld(&(bar)[XB_TMO])) break; if (_sp > XB_SPIN_CAP) { atomicAdd(&(bar)[XB_TMO], 1u); break; } } } } while (0)
struct XcdBarrier { unsigned* bar; unsigned x; volatile LAS unsigned* st; };
__device__ __forceinline__ XcdBarrier xcd_barrier_post(unsigned* bar, volatile LAS unsigned* st) {
    XcdBarrier b; b.bar = bar; b.x = xb_xcc_id(); b.st = st;
    if (threadIdx.x == 0) (void)xb_add(&bar[XB_XCNT(b.x)], 1u);
    return b;
}
__device__ __forceinline__ void xcd_barrier_complete(unsigned* bar, unsigned x, unsigned& nloc, unsigned& nx) {
    const unsigned G = gridDim.x * gridDim.y * gridDim.z;
    unsigned sum, cnt, mine, sp = 0u;
    for (;;) {
        sum = 0u; cnt = 0u; mine = 0u;
#pragma unroll
        for (unsigned j = 0; j < 16; ++j) { const unsigned c = xb_ld(&bar[XB_XCNT(j)]); sum += c; cnt += (c > 0u) ? 1u : 0u; }
        mine = xb_ld(&bar[XB_XCNT(x)]);
        if (sum == G) break;
        __builtin_amdgcn_s_sleep(1);
        if ((++sp & 255u) == 0u) { if (xb_ld(&bar[XB_TMO])) break; if (sp > XB_SPIN_CAP) { atomicAdd(&bar[XB_TMO], 1u); break; } }
    }
    nloc = mine > 0u ? mine : 1u; nx = cnt > 0u ? cnt : 1u;
}
__device__ __forceinline__ void xcd_barrier(const XcdBarrier& b) {
    asm volatile("s_waitcnt vmcnt(0)" ::: "memory");
    __syncthreads();
    if (threadIdx.x == 0) {
        unsigned* bar = b.bar;
        __builtin_amdgcn_s_waitcnt(0);
        unsigned nloc = b.st[0], nx = b.st[1];
        if (nloc == 0u) { xcd_barrier_complete(bar, b.x, nloc, nx); b.st[0] = nloc; b.st[1] = nx; }
        const unsigned old = xb_add(&bar[XB_XSUB(b.x)], 1u);
        const unsigned gen = old / nloc;
        if (old + 1u == (gen + 1u) * nloc) {
            __builtin_amdgcn_fence(__ATOMIC_RELEASE, "agent");
            asm volatile("s_waitcnt vmcnt(0)" ::: "memory");
            const unsigned og = xb_add(&bar[XB_TOP], 1u);
            const unsigned tg = og / nx;
            if (og + 1u == (tg + 1u) * nx) xb_add(&bar[XB_TOPGEN], 1u);
            else XB_SPIN(xb_ld(&bar[XB_TOPGEN]) == tg, bar);
            __builtin_amdgcn_fence(__ATOMIC_ACQUIRE, "agent");
            xb_add(&bar[XB_XGEN(b.x)], 1u);
            asm volatile("s_waitcnt vmcnt(0)" ::: "memory");
        } else {
            XB_SPIN(xb_ld(&bar[XB_XGEN(b.x)]) == gen, bar);
            __builtin_amdgcn_fence(__ATOMIC_ACQUIRE, "agent");
            asm volatile("s_waitcnt vmcnt(0)" ::: "memory");
        }
    }
    __syncthreads();
}

struct Args { const float* in[30]; float* out; unsigned char* ws; int ph_lo, ph_hi; };
struct Ctx {
    LAS unsigned char* lds; unsigned char* ws; const float* const* in; float* out;
    int tid, lane, wave, vcu, G, gw, NGW;
};
enum { I_X = 0, I_P, I_NMIX, I_WIN, I_AR, I_AI, I_LDT, I_BR, I_BI, I_CR, I_CI, I_D, I_WGLU, I_SGN, I_SGW, I_SGB, I_WSP, I_WOUT, I_NFFN, I_WRG, I_BRG, I_WRE, I_BRE, I_WEG, I_WEU, I_WED, I_NPLE, I_WPG, I_WPP, I_NFIN };

__device__ __forceinline__ void tr_item(const float* W, int ldn, int K, const float* scale, f16* WT, int dst_row0, LAS float* scr, int k0, int n0, int lane) {
#pragma unroll 8
    for (int i = 0; i < 32; ++i) { const int kk = 2 * i + (lane >> 5); float v = W[(size_t)(k0 + kk) * ldn + n0 + (lane & 31)]; if (scale) v *= scale[k0 + kk]; scr[kk * 33 + (lane & 31)] = v; }
    LDS_WAIT(); asm volatile("" ::: "memory");
    const int c = lane & 7;
#pragma unroll
    for (int j = 0; j < 4; ++j) { const int n = (lane >> 3) + 8 * j; const LAS float* s = scr + (8 * c) * 33 + n;
        u32x4 o; o.x = pkh(s[0 * 33], s[1 * 33]); o.y = pkh(s[2 * 33], s[3 * 33]); o.z = pkh(s[4 * 33], s[5 * 33]); o.w = pkh(s[6 * 33], s[7 * 33]);
        *(u32x4*)(WT + (size_t)(dst_row0 + n) * K + k0 + 8 * c) = o; }
    LDS_WAIT(); asm volatile("" ::: "memory");
}
__device__ __forceinline__ int map_win(int n) { return n < 1024 ? n : (n < 1536 ? 3072 + (n - 1024) : n - 512); }
__device__ __forceinline__ int map_glu(int n) { return n < 1024 ? 256 * (n >> 7) + (n & 127) : 256 * ((n - 1024) >> 7) + 128 + ((n - 1024) & 127); }
__device__ __forceinline__ int map_il(int n, int half) { return 256 * (n >> 7) + 128 * half + (n & 127); }

__device__ __forceinline__ void sincos_small(float x, float& s, float& c) {
    const float q = rintf(x * 0.63661977236758f);
    float r = fmaf(-q, 1.5707962513e+00f, x); r = fmaf(-q, 7.5497894159e-08f, r); r = fmaf(-q, 5.3903029534e-15f, r);
    const float r2 = r * r;
    const float sp = r * (1.0f + r2 * (-1.6666667163e-01f + r2 * (8.3333337680e-03f + r2 * (-1.9841270114e-04f + r2 * 2.7557314297e-06f))));
    const float cp = 1.0f + r2 * (-0.5f + r2 * (4.1666667908e-02f + r2 * (-1.3888889225e-03f + r2 * (2.4801587642e-05f + r2 * -2.7557314297e-07f))));
    const int qi = ((int)q) & 3;
    s = (qi == 0) ? sp : (qi == 1) ? cp : (qi == 2) ? -sp : -cp;
    c = (qi == 0) ? cp : (qi == 1) ? -sp : (qi == 2) ? -cp : sp;
}

__device__ __forceinline__ void s5_precompute(Ctx& F, int layer) {
    if (blockIdx.x >= 256) return;
    const int g = blockIdx.x >> 3, p = blockIdx.x & 7, tid = F.tid;
    LAS float* lam = (LAS float*)F.lds;
    LAS float* bb = lam + 33 * 64 * 2;
    LAS float* cm = bb + 64 * 16 * 2;
    LAS float* kf = cm + 16 * 64 * 2;
    const float* a_re = F.in[I_AR] + layer * 2048; const float* a_im = F.in[I_AI] + layer * 2048; const float* ldt = F.in[I_LDT] + layer * 32;
    const float* b_re = F.in[I_BR] + (size_t)layer * 32768; const float* b_im = F.in[I_BI] + (size_t)layer * 32768;
    const float* c_re = F.in[I_CR] + (size_t)layer * 32768; const float* c_im = F.in[I_CI] + (size_t)layer * 32768;
    f16* s5a = (f16*)(F.ws + WS_W + W_S5A) + (size_t)g * 256 * 512;
    f16* s5b = (f16*)(F.ws + WS_W + W_S5B) + (size_t)g * 512 * AK;
    float* lam32 = (float*)(F.ws + WS_SMALL);
    if (tid < 64) {
        const int n = tid; const float dt = expf(ldt[g]); const float ar = a_re[g * 64 + n], ai = a_im[g * 64 + n];
        const float mag = expf(ar * dt); float sn, cs; sincos_small(ai * dt, sn, cs);
        const float lr = mag * cs, li = mag * sn;
        float pr = 1.f, pi = 0.f;
        for (int mm = 0; mm <= 32; ++mm) { lam[(mm * 64 + n) * 2] = pr; lam[(mm * 64 + n) * 2 + 1] = pi; const float t = pr * lr - pi * li; pi = pr * li + pi * lr; pr = t; }
        const float den = ar * ar + ai * ai, nr = lr - 1.0f;
        const float cre = (nr * ar + li * ai) / den, cim = (li * ar - nr * ai) / den;
        for (int c = 0; c < 16; ++c) { const float br = b_re[(size_t)(g * 64 + n) * 16 + c], bi = b_im[(size_t)(g * 64 + n) * 16 + c];
            bb[(n * 16 + c) * 2] = cre * br - cim * bi; bb[(n * 16 + c) * 2 + 1] = cre * bi + cim * br; }
    } else {
        for (int idx = tid - 64; idx < 1024; idx += 448) { cm[idx * 2] = c_re[(size_t)g * 1024 + idx]; cm[idx * 2 + 1] = c_im[(size_t)g * 1024 + idx]; }
    }
    __syncthreads();
    for (int o = tid; o < 1024; o += 512) {
        const int j = o >> 8, c = (o >> 4) & 15, c2 = o & 15, lag = 4 * p + j; float val = 0.f;
        for (int n = 0; n < 64; ++n) { const float cr = cm[(c * 64 + n) * 2], ci = cm[(c * 64 + n) * 2 + 1], lr = lam[(lag * 64 + n) * 2], li = lam[(lag * 64 + n) * 2 + 1];
            const float wr = cr * lr - ci * li, wi = cr * li + ci * lr; val += wr * bb[(n * 16 + c2) * 2] - wi * bb[(n * 16 + c2) * 2 + 1]; }
        kf[o] = val * 64.0f;
    }
    __syncthreads();
    for (int idx = tid; idx < 2048; idx += 512) {
        const int j = idx >> 9, t = (idx >> 4) & 31, c = idx & 15, lag = 4 * p + j;
        if (t >= lag) { f16* dst = s5b + (size_t)(t * 16 + c) * AK + 128 + (t - lag) * 16; const LAS float* k = kf + j * 256 + c * 16;
            u32x4 w0, w1; w0.x = pkh(k[0], k[1]); w0.y = pkh(k[2], k[3]); w0.z = pkh(k[4], k[5]); w0.w = pkh(k[6], k[7]); w1.x = pkh(k[8], k[9]); w1.y = pkh(k[10], k[11]); w1.z = pkh(k[12], k[13]); w1.w = pkh(k[14], k[15]);
            *(u32x4*)dst = w0; *(u32x4*)(dst + 8) = w1; }
    }
    for (int idx = tid; idx < 2048; idx += 512) {
        const int tt = idx >> 9, c = (idx >> 5) & 15, s = idx & 31, t = 4 * p + tt;
        if (s > t) { f16* dst = s5b + (size_t)(t * 16 + c) * AK + 128 + s * 16; const u32x4 z = {0u, 0u, 0u, 0u}; *(u32x4*)dst = z; *(u32x4*)(dst + 8) = z; }
    }
    for (int idx = tid; idx < 4096; idx += 512) {
        const int tt = idx >> 10, c = (idx >> 6) & 15, n = idx & 63, t = 4 * p + tt;
        const float cr = cm[(c * 64 + n) * 2], ci = cm[(c * 64 + n) * 2 + 1], lr = lam[((t + 1) * 64 + n) * 2], li = lam[((t + 1) * 64 + n) * 2 + 1];
        f16* dst = s5b + (size_t)(t * 16 + c) * AK;
        dst[n] = (f16)((cr * lr - ci * li) * 64.0f); dst[64 + n] = (f16)(-(cr * li + ci * lr) * 64.0f);
    }
    for (int idx = tid; idx < 4096; idx += 512) {
        const int ss = idx >> 10, n = (idx >> 4) & 63, c2 = idx & 15, s = 4 * p + ss;
        const float lr = lam[((31 - s) * 64 + n) * 2], li = lam[((31 - s) * 64 + n) * 2 + 1], br = bb[(n * 16 + c2) * 2], bi = bb[(n * 16 + c2) * 2 + 1];
        s5a[(size_t)n * 512 + s * 16 + c2] = (f16)((lr * br - li * bi) * 256.0f); s5a[(size_t)(64 + n) * 512 + s * 16 + c2] = (f16)((lr * bi + li * br) * 256.0f);
    }
    for (int idx = tid; idx < 1024; idx += 512) { const int row = 128 + (idx >> 3), ch = idx & 7; const u32x4 z = {0u, 0u, 0u, 0u}; *(u32x4*)(s5a + (size_t)row * 512 + p * 64 + ch * 8) = z; }
    if (p == 0 && tid < 64) { lam32[(g * 64 + tid) * 2] = lam[(32 * 64 + tid) * 2]; lam32[(g * 64 + tid) * 2 + 1] = lam[(32 * 64 + tid) * 2 + 1]; }
    __syncthreads();
}

__device__ __forceinline__ void prologue(Ctx& F, int layer) {
    s5_precompute(F, layer);
    LAS float* scr = (LAS float*)(F.lds + F.wave * 16384);
    unsigned char* W = F.ws + WS_W;
    const float* nmix = F.in[I_NMIX] + layer * 1024; const float* nffn = F.in[I_NFFN] + layer * 1024; const float* nple = F.in[I_NPLE] + layer * 1024;
    constexpr int IT_E = 32 * 256;
    constexpr int IT_WIN = 16 * 112, IT_GLU = 8 * 64, IT_SP = 8 * 32, IT_OUT = 16 * 32, IT_PG = 16 * 32, IT_PP = 4 * 32;
    constexpr int NITEMS = 3 * IT_E + IT_WIN + IT_GLU + IT_SP + IT_OUT + IT_PG + IT_PP;
    for (int it = F.gw; it < NITEMS; it += F.NGW) {
        int r = it;
        if (r < 2 * IT_E) { const int up = r >= IT_E; if (up) r -= IT_E; const int e = r >> 8, q = r & 255, kb = q >> 4, nb = q & 15;
            const float* src = F.in[up ? I_WEU : I_WEG] + ((size_t)layer * 32 + e) * 1024 * 512;
            tr_item(src, 512, 1024, nffn, (f16*)(W + W_GU) + (size_t)e * 1024 * 1024, map_il(nb * 32, up), scr, kb * 64, nb * 32, F.lane); continue; } r -= 2 * IT_E;
        if (r < IT_E) { const int e = r >> 8, q = r & 255, kb = q >> 5, nb = q & 31;
            tr_item(F.in[I_WED] + ((size_t)layer * 32 + e) * 512 * 1024, 1024, 512, nullptr, (f16*)(W + W_D) + (size_t)e * 1024 * 512, nb * 32, scr, kb * 64, nb * 32, F.lane); continue; } r -= IT_E;
        if (r < IT_WIN) { const int kb = r / 112, nb = r % 112;
            tr_item(F.in[I_WIN] + (size_t)layer * 1024 * 3584, 3584, 1024, nmix, (f16*)(W + W_IN), map_win(nb * 32), scr, kb * 64, nb * 32, F.lane); continue; } r -= IT_WIN;
        if (r < IT_GLU) { const int kb = r >> 6, nb = r & 63;
            tr_item(F.in[I_WGLU] + (size_t)layer * 512 * 2048, 2048, 512, nullptr, (f16*)(W + W_GLU), map_glu(nb * 32), scr, kb * 64, nb * 32, F.lane); continue; } r -= IT_GLU;
        if (r < IT_SP) { const int kb = r >> 5, nb = r & 31;
            tr_item(F.in[I_WSP] + (size_t)layer * 512 * 1024, 1024, 512, nullptr, (f16*)(W + W_SP), nb * 32, scr, kb * 64, nb * 32, F.lane); continue; } r -= IT_SP;
        if (r < IT_OUT) { const int kb = r >> 5, nb = r & 31;
            tr_item(F.in[I_WOUT] + (size_t)layer * 1024 * 1024, 1024, 1024, nullptr, (f16*)(W + W_OUT), nb * 32, scr, kb * 64, nb * 32, F.lane); continue; } r -= IT_OUT;
        if (r < IT_PG) { const int kb = r >> 5, nb = r & 31;
            tr_item(F.in[I_WPG] + (size_t)layer * 1024 * 1024, 1024, 1024, nple, (f16*)(W + W_PG), nb * 32, scr, kb * 64, nb * 32, F.lane); continue; } r -= IT_PG;
        { const int kb = r >> 5, nb = r & 31;
            tr_item(F.in[I_WPP] + (size_t)layer * 256 * 1024, 1024, 256, nullptr, (f16*)(W + W_PP), nb * 32, scr, kb * 64, nb * 32, F.lane); }
    }
    const int gt = blockIdx.x * 512 + F.tid, NGT = F.G * 512;
    { const float* wre = F.in[I_WRE] + (size_t)layer * 1024 * 32; const float* wrg = F.in[I_WRG] + (size_t)layer * 1024 * 4; f16* wr16 = (f16*)(W + W_R);
      for (int i = gt; i < 48 * 1024; i += NGT) { const int n = i >> 10, k = i & 1023; const float v = n < 32 ? wre[k * 32 + n] : (n < 36 ? wrg[k * 4 + (n - 32)] : 0.f); wr16[i] = (f16)(v * nffn[k]); } }
    { const float* sw = F.in[I_SGW] + (size_t)layer * 65536; f16* wsm = (f16*)(W + W_SM);
      for (int i = gt; i < 65536; i += NGT) { const int t = (i >> 7) & 127, s = i & 127; wsm[i] = (f16)(s <= t ? sw[i] : 0.f); } }
    { const float* p = F.in[I_P] + (size_t)layer * T * 256; f16* p16 = (f16*)(F.ws + WS_P16);
      for (size_t i = (size_t)gt * 4; i < (size_t)T * 256; i += (size_t)NGT * 4) { const f32x4 v = *(const f32x4*)(p + i); u32x2 w; w.x = pkh(v[0], v[1]); w.y = pkh(v[2], v[3]); *(u32x2*)(p16 + i) = w; } }
    if (layer == 0) {
        const float* x = F.in[I_X]; f16* h16 = (f16*)(F.ws + WS_H16); float* rsm = (float*)(F.ws + WS_RSM);
        for (int row = F.gw; row < T; row += F.NGW) {
            const f32x4* xr = (const f32x4*)(x + (size_t)row * DM) + F.lane; f32x4 v[4]; float s = 0.f;
#pragma unroll
            for (int j = 0; j < 4; ++j) { v[j] = xr[64 * j]; s += (v[j][0] * v[j][0] + v[j][1] * v[j][1]) + (v[j][2] * v[j][2] + v[j][3] * v[j][3]); }
            s = wave_sum(s);
            u32x2* o = (u32x2*)(h16 + (size_t)row * DM) + F.lane;
#pragma unroll
            for (int j = 0; j < 4; ++j) { u32x2 w; w.x = pkh(v[j][0], v[j][1]); w.y = pkh(v[j][2], v[j][3]); o[64 * j] = w; }
            if (F.lane == 0) rsm[row] = 1.0f / sqrtf(s * (1.0f / DM) + EPS);
        }
    } else {
        const u64* ssq = (const u64*)(F.ws + WS_CTL + CTL_SSQ1); float* rsm = (float*)(F.ws + WS_RSM);
        for (int i = gt; i < T; i += NGT) rsm[i] = rstd_u64(ssq, i);
    }
}

__device__ __forceinline__ void sgu_phase(Ctx& F, int layer) {
    LAS f16* vt = (LAS f16*)F.lds;
    LAS float* part = (LAS float*)(F.lds + 128 * 272);
    LAS f16* rs16 = (LAS f16*)(F.lds + 128 * 272 + 2048);
    const float* nw = F.in[I_SGN] + layer * 512; const float* bs = F.in[I_SGB] + layer * 512;
    const f16* wsm = (const f16*)(F.ws + WS_W + W_SM); const f16* VT = (const f16*)(F.ws + WS_ACT + A_VT); f16* U16 = (f16*)(F.ws + WS_ACT + A_U16);
    const int tid = F.tid, fr = F.lane & 15, fq = F.lane >> 4, wave = F.wave;
    for (int it = F.vcu; it < 1024; it += F.G) {
        const int h = it & 3, tok0 = (it >> 2) * 128;
#pragma unroll
        for (int q = 0; q < 4; ++q) { const int row = (tid >> 4) + 32 * q, ch = tid & 15;
            *(LAS u32x4*)(vt + row * 136 + ch * 8) = *(const u32x4*)(VT + (size_t)(h * 128 + row) * T + tok0 + ch * 8); }
        __syncthreads();
        { const int s = tid & 127, pp = tid >> 7; float a = 0.f;
          for (int d = 0; d < 32; ++d) { const float v = (float)vt[(pp * 32 + d) * 136 + s]; a += v * v; }
          part[pp * 128 + s] = a; }
        __syncthreads();
        if (tid < 128) { const float sm = (part[tid] + part[128 + tid]) + (part[256 + tid] + part[384 + tid]); rs16[tid] = (f16)(1.0f / sqrtf(sm * (1.0f / 128.0f) + EPS)); }
        __syncthreads();
        const int t0 = 16 * wave, nk = (16 * wave + 15) / 32 + 1;
        f32x4 acc[8];
#pragma unroll
        for (int j = 0; j < 8; ++j) acc[j] = (f32x4){0.f, 0.f, 0.f, 0.f};
        for (int kk = 0; kk < nk; ++kk) {
            f16x8 a = *(const f16x8*)(wsm + (size_t)(h * 128 + t0 + fr) * 128 + 32 * kk + 8 * fq);
            const f16x8 r = *(const LAS f16x8*)(rs16 + 32 * kk + 8 * fq);
            a = a * r;
#pragma unroll
            for (int j = 0; j < 8; ++j) { const f16x8 b = *(const LAS f16x8*)(vt + (16 * j + fr) * 136 + 32 * kk + 8 * fq); acc[j] = __builtin_amdgcn_mfma_f32_16x16x32_f16(b, a, acc[j], 0, 0, 0); }
        }
        const int t = t0 + fr; const float bsv = bs[h * 128 + t]; f16* urow = U16 + (size_t)(tok0 + t) * 512 + h * 128;
#pragma unroll
        for (int j = 0; j < 8; ++j) { const int d = 16 * j + 4 * fq; const f32x4 nv = *(const f32x4*)(nw + h * 128 + d);
            const f16x4 uu = *(const f16x4*)(urow + d); u32x2 w;
            w.x = pkh((float)uu[0] * (acc[j][0] * nv[0] + bsv), (float)uu[1] * (acc[j][1] * nv[1] + bsv));
            w.y = pkh((float)uu[2] * (acc[j][2] * nv[2] + bsv), (float)uu[3] * (acc[j][3] * nv[3] + bsv));
            *(u32x2*)(urow + d) = w; }
        __syncthreads();
    }
}

__device__ __forceinline__ void s5_scan(Ctx& F) {
    const int idx = blockIdx.x * 512 + F.tid; if (idx >= 32 * 16 * 64) return;
    const int n = idx & 63, b = (idx >> 6) & 15, g = idx >> 10;
    const float* lam32 = (const float*)(F.ws + WS_SMALL); const float lr = lam32[(g * 64 + n) * 2], li = lam32[(g * 64 + n) * 2 + 1];
    const float* sst = (const float*)(F.ws + WS_SST) + (size_t)(g * 1024 + b * 64) * 128; f16* ax = (f16*)(F.ws + WS_ACT + A_AEXT) + (size_t)(g * 1024 + b * 64) * AK;
    float hr = 0.f, hi = 0.f;
    for (int k = 0; k < NCHK; ++k) {
        ax[(size_t)k * AK + n] = (f16)hr; ax[(size_t)k * AK + 64 + n] = (f16)hi;
        const float sr = sst[k * 128 + n], si = sst[k * 128 + 64 + n];
        const float t = lr * hr - li * hi + sr; hi = lr * hi + li * hr + si; hr = t;
    }
}

__device__ __forceinline__ void router_phase(Ctx& F, int layer) {
    LAS f16* wl = (LAS f16*)F.lds;
    LAS float* lg = (LAS float*)(F.lds + 100 * 1024);
    LAS int* hist = (LAS int*)(F.lds + 126 * 1024);
    const f16* wr16 = (const f16*)(F.ws + WS_W + W_R); const f16* H16 = (const f16*)(F.ws + WS_H16);
    int* cnt = (int*)(F.ws + WS_CTL) + CW_CNT + layer * 32;
    int* ldst = (int*)(F.ws + WS_LDST); float* lw = (float*)(F.ws + WS_LW); float* lrs = (float*)(F.ws + WS_LRS);
    const float* brg = F.in[I_BRG] + layer * 4; const float* bre = F.in[I_BRE] + layer * 32;
    const int tid = F.tid, lane = F.lane, fr = lane & 15, fq = lane >> 4, wave = F.wave;
    for (int q = 0; q < 12; ++q) { const int idx = tid + 512 * q, row = idx >> 7, ch = idx & 127; *(LAS u32x4*)(wl + row * 1032 + ch * 8) = *(const u32x4*)(wr16 + row * 1024 + ch * 8); }
    for (int blk = blockIdx.x; blk < T / 128; blk += F.G) {
        if (tid < 64) hist[tid] = 0;
        __syncthreads();
        const int tokbase = blk * 128 + wave * 16;
        f32x4 acc[3]; acc[0] = acc[1] = acc[2] = (f32x4){0.f, 0.f, 0.f, 0.f}; float ss = 0.f;
        const f16* arow = H16 + (size_t)(tokbase + fr) * 1024 + 8 * fq;
#pragma unroll 4
        for (int kk = 0; kk < 32; ++kk) {
            const f16x8 a = *(const f16x8*)(arow + 32 * kk);
#pragma unroll
            for (int i = 0; i < 8; ++i) { const float v = (float)a[i]; ss += v * v; }
#pragma unroll
            for (int j = 0; j < 3; ++j) { const f16x8 b = *(const LAS f16x8*)(wl + (16 * j + fr) * 1032 + 32 * kk + 8 * fq); acc[j] = __builtin_amdgcn_mfma_f32_16x16x32_f16(b, a, acc[j], 0, 0, 0); }
        }
        ss += __shfl_xor(ss, 16); ss += __shfl_xor(ss, 32);
#pragma unroll
        for (int j = 0; j < 3; ++j)
#pragma unroll
            for (int i = 0; i < 4; ++i) lg[(wave * 16 + fr) * 48 + 16 * j + 4 * fq + i] = acc[j][i];
        LDS_WAIT(); asm volatile("" ::: "memory");
        int e0 = 0, e1 = 0, pos0 = 0, pos1 = 0; float w0 = 0.f, w1 = 0.f, rstd = 0.f;
        if (lane < 16) {
            rstd = 1.0f / sqrtf(ss * (1.0f / DM) + EPS);
            const LAS float* L = lg + (wave * 16 + lane) * 48;
            float gl[4];
#pragma unroll
            for (int i = 0; i < 4; ++i) gl[i] = L[32 + i] * rstd + brg[i];
            int g = 0; float gm = gl[0];
#pragma unroll
            for (int i = 1; i < 4; ++i) if (gl[i] > gm) { gm = gl[i]; g = i; }
            float den = 0.f;
#pragma unroll
            for (int i = 0; i < 4; ++i) den += __expf(gl[i] - gm);
            const float gwt = 1.0f / den;
            float v0 = -3.0e38f, v1 = -3.0e38f; int i0 = 0, i1 = 0;
            for (int i = 0; i < 8; ++i) { const float v = L[8 * g + i] * rstd + bre[8 * g + i];
                if (v > v0) { v1 = v0; i1 = i0; v0 = v; i0 = i; } else if (v > v1) { v1 = v; i1 = i; } }
            w0 = 1.0f / (1.0f + __expf(v1 - v0)); w1 = (1.0f - w0) * gwt; w0 *= gwt;
            e0 = 8 * g + i0; e1 = 8 * g + i1;
            pos0 = __hip_atomic_fetch_add(&hist[e0], 1, __ATOMIC_RELAXED, __HIP_MEMORY_SCOPE_WORKGROUP);
            pos1 = __hip_atomic_fetch_add(&hist[e1], 1, __ATOMIC_RELAXED, __HIP_MEMORY_SCOPE_WORKGROUP);
        }
        __syncthreads();
        if (tid < 32) { const int c = hist[tid]; hist[32 + tid] = c ? (int)atomicAdd((unsigned*)(cnt + tid), (unsigned)c) : 0; }
        __syncthreads();
        if (lane < 16) {
            const int tk = tokbase + lane;
            const size_t o0 = (size_t)e0 * T + hist[32 + e0] + pos0, o1 = (size_t)e1 * T + hist[32 + e1] + pos1;
            ldst[o0] = 2 * tk; lw[o0] = w0; lrs[o0] = rstd; ldst[o1] = 2 * tk + 1; lw[o1] = w1; lrs[o1] = rstd;
        }
        __syncthreads();
    }
}

__device__ __forceinline__ void p9_phase(Ctx& F) {
    float* hb = (float*)(F.ws + WS_HB); f16* h16 = (f16*)(F.ws + WS_H16); const f16* c16 = (const f16*)(F.ws + WS_ACT + A_C16); float* rs = (float*)(F.ws + WS_RS);
    for (int row = F.gw; row < T; row += F.NGW) {
        f32x4* hr = (f32x4*)(hb + (size_t)row * DM) + F.lane; const u32x2* c0 = (const u32x2*)(c16 + (size_t)(2 * row) * DM) + F.lane; const u32x2* c1 = (const u32x2*)(c16 + (size_t)(2 * row + 1) * DM) + F.lane;
        u32x2* o = (u32x2*)(h16 + (size_t)row * DM) + F.lane; float s = 0.f;
#pragma unroll
        for (int j = 0; j < 4; ++j) { f32x4 v = hr[64 * j]; const f16x4 a = __builtin_bit_cast(f16x4, c0[64 * j]), b = __builtin_bit_cast(f16x4, c1[64 * j]);
#pragma unroll
            for (int i = 0; i < 4; ++i) { v[i] = v[i] + ((float)a[i] + (float)b[i]); s += v[i] * v[i]; }
            hr[64 * j] = v; u32x2 w; w.x = pkh(v[0], v[1]); w.y = pkh(v[2], v[3]); o[64 * j] = w; }
        s = wave_sum(s);
        if (F.lane == 0) rs[row] = 1.0f / sqrtf(s * (1.0f / DM) + EPS);
    }
}
__device__ __forceinline__ void final_phase(Ctx& F) {
    const u64* ssq = (const u64*)(F.ws + WS_CTL + CTL_SSQ2); const f32x4* gf = (const f32x4*)F.in[I_NFIN] + F.lane;
    for (int row = F.gw; row < T; row += F.NGW) {
        const float r = rstd_u64(ssq, row); f32x4* o = (f32x4*)(F.out + (size_t)row * DM) + F.lane;
#pragma unroll
        for (int j = 0; j < 4; ++j) o[64 * j] = o[64 * j] * r * gf[64 * j];
    }
}

constexpr int PH_PER_LAYER = 12, N_PHASES = 1 + 2 * PH_PER_LAYER;

__global__ void __launch_bounds__(NWAVES * 64, 2) mega_fwd(Args args) {
    extern __shared__ __attribute__((aligned(16))) unsigned char lds_raw[];
    Ctx F;
    F.lds = (LAS unsigned char*)lds_raw; F.ws = args.ws; F.in = args.in; F.out = args.out;
    F.tid = threadIdx.x; F.lane = F.tid & 63; F.wave = __builtin_amdgcn_readfirstlane(F.tid >> 6);
    F.G = gridDim.x; { const int bx = blockIdx.x; F.vcu = (F.G % 8 == 0) ? (bx % 8) * (F.G / 8) + bx / 8 : bx; }
    F.gw = F.vcu * NWAVES + F.wave; F.NGW = F.G * NWAVES;
    volatile LAS unsigned* MISC = (volatile LAS unsigned*)(F.lds + MISC_OFF);
    LAS int* tbl = (LAS int*)(F.lds + LDSX_OFF);
    for (int u = F.tid; u < (LDS_BYTES - RING_BYTES) / 4; u += NWAVES * 64) ((LAS unsigned*)(F.lds + RING_BYTES))[u] = 0u;
    __syncthreads();
    unsigned* ctl = (unsigned*)(F.ws + WS_CTL);
    XcdBarrier bar; bar.bar = ctl + CW_BAR; bar.x = 0; bar.st = nullptr;
    const int lo = args.ph_lo, hi = args.ph_hi;
    const bool use_bar = (hi - lo) > 1;
    if (use_bar) bar = xcd_barrier_post(ctl + CW_BAR, MISC + 8);
    unsigned char* W = F.ws + WS_W; unsigned char* ACT = F.ws + WS_ACT;
    float* HB = (float*)(F.ws + WS_HB); f16* H16 = (f16*)(F.ws + WS_H16);
    LAS unsigned char* ring = F.lds;

#ifndef PHMASK
#define PHMASK 0x1FFF
#endif
#define IN(k) (lo <= (k) && (k) < hi && ((PHMASK >> ((k) == 0 ? 12 : ((k) - 1) % 12)) & 1))
#define SEAM(k) do { if (use_bar && IN(k) && IN((k) + 1)) xcd_barrier(bar); } while (0)
    if (IN(0)) prologue(F, 0);
    SEAM(0);
#define LAYER_BODY(layer, base) do { \
    if (IN((base) + 0)) {              \
        const float* ssq = (const float*)(F.ws + WS_RSM); \
        { pg8::SchedStd S; S.init(T / 256, 12, F.G, (int)blockIdx.x, H16, W + W_IN, (size_t)256 * 2048, (size_t)256 * 2048); \
          EpiP1Main E{ssq, (f16*)(ACT + A_AEXT), (f16*)(ACT + A_U16), (f16*)(ACT + A_GA), (f16*)(ACT + A_GB)}; \
          pg8::gemm_phase<EpiP1Main, pg8::SchedStd, false>(ring, 16, 2048u, 2048u, S, E); } \
        __syncthreads(); \
        { pg8::SchedStd S; S.init(2, T / 256, F.G, (int)blockIdx.x, W + W_V, H16, (size_t)256 * 2048, (size_t)256 * 2048); \
          EpiP1VT E{ssq, (f16*)(ACT + A_VT)}; \
          pg8::gemm_phase<EpiP1VT, pg8::SchedStd, false>(ring, 16, 2048u, 2048u, S, E); } \
    } \
    SEAM((base) + 0); \
    if (IN((base) + 1)) {              \
        sgu_phase(F, (layer)); \
        __syncthreads(); \
        { pg8::SchedGrp S; S.nPM = 4; S.nPN = 1; S.ntot = 128; S.G = F.G; S.c = F.vcu; S.A = (const char*)(ACT + A_AEXT) + 256; S.B = (const char*)(W + W_S5A); \
          S.ga = (size_t)1024 * AK * 2; S.gb = (size_t)256 * 1024; S.ta = (size_t)256 * AK * 2; S.tb = 0; \
          EpiS5a E{(float*)(F.ws + WS_SST)}; \
          pg8::gemm_phase<EpiS5a, pg8::SchedGrp, false>(ring, 8, (unsigned)(AK * 2), 1024u, S, E); } \
    } \
    SEAM((base) + 1); \
    if (IN((base) + 2)) {              \
        s5_scan(F); \
        { pg8::SchedStd S; S.init(T / 256, 4, F.G, (int)blockIdx.x, ACT + A_U16, W + W_SP, (size_t)256 * 1024, (size_t)256 * 1024); \
          EpiP3a E{(f16*)(ACT + A_GB)}; \
          pg8::gemm_phase<EpiP3a, pg8::SchedStd, false>(ring, 8, 1024u, 1024u, S, E); } \
    } \
    SEAM((base) + 2); \
    if (IN((base) + 3)) {              \
        pg8::SchedGrp S; S.nPM = 4; S.nPN = 2; S.ntot = 256; S.G = F.G; S.c = F.vcu; S.A = (const char*)(ACT + A_AEXT); S.B = (const char*)(W + W_S5B); \
        S.ga = (size_t)1024 * AK * 2; S.gb = (size_t)512 * AK * 2; S.ta = (size_t)256 * AK * 2; S.tb = (size_t)256 * AK * 2; \
        EpiS5b E{(const f16*)(ACT + A_AEXT), F.in[I_D] + (layer) * 512, (f16*)(ACT + A_VT)}; \
        pg8::gemm_phase<EpiS5b, pg8::SchedGrp, false>(ring, 10, (unsigned)(AK * 2), (unsigned)(AK * 2), S, E); \
    } \
    SEAM((base) + 3); \
    if (IN((base) + 4)) {              \
        pg8::SchedStd S; S.init(T / 256, 8, F.G, (int)blockIdx.x, ACT + A_VT, W + W_GLU, (size_t)256 * 1024, (size_t)256 * 1024); \
        EpiP3b E{(const f16*)(ACT + A_GA), (f16*)(ACT + A_GB)}; \
        pg8::gemm_phase<EpiP3b, pg8::SchedStd, false>(ring, 8, 1024u, 1024u, S, E); \
    } \
    SEAM((base) + 4); \
    if (IN((base) + 5)) {              \
        pg8::SchedStd S; S.init(T / 256, 4, F.G, (int)blockIdx.x, ACT + A_GB, W + W_OUT, (size_t)256 * 2048, (size_t)256 * 2048); \
        EpiP4 E{(layer) == 0 ? F.in[I_X] : (const float*)HB, HB, H16}; \
        pg8::gemm_phase<EpiP4, pg8::SchedStd, false>(ring, 16, 2048u, 2048u, S, E); \
    } \
    SEAM((base) + 5); \
    if (IN((base) + 6)) router_phase(F, (layer)); \
    SEAM((base) + 6); \
    if (IN((base) + 7)) {              \
        const int* cnt = (const int*)(F.ws + WS_CTL) + CW_CNT + (layer) * 32; \
        if (F.tid == 0) { int s = 0; for (int e = 0; e < 32; ++e) { tbl[e] = s; s += (__hip_atomic_load(cnt + e, __ATOMIC_RELAXED, __HIP_MEMORY_SCOPE_AGENT) + 255) >> 8; } tbl[32] = s; } \
        __syncthreads(); \
        pg8::SchedMoE S; S.tbl = tbl; S.cnt = cnt; S.ldst = (const int*)(F.ws + WS_LDST); S.G = F.G; S.c = F.vcu; \
        S.A = (const char*)H16; S.B = (const char*)(W + W_GU); S.ta = 0; S.eb = (size_t)1024 * 2048; S.tbB = (size_t)256 * 2048; S.gather = true; \
        EpiP7 E{(const float*)(F.ws + WS_LRS), (f16*)(ACT + A_HID)}; \
        pg8::gemm_phase<EpiP7, pg8::SchedMoE, true>(ring, 16, 2048u, 2048u, S, E); \
    } \
    SEAM((base) + 7); \
    if (IN((base) + 8)) {              \
        const int* cnt = (const int*)(F.ws + WS_CTL) + CW_CNT + (layer) * 32; \
        if (F.tid == 0) { int s = 0; for (int e = 0; e < 32; ++e) { tbl[e] = s; s += (__hip_atomic_load(cnt + e, __ATOMIC_RELAXED, __HIP_MEMORY_SCOPE_AGENT) + 255) >> 8; } tbl[32] = s; } \
        __syncthreads(); \
        pg8::SchedMoE S; S.tbl = tbl; S.cnt = cnt; S.ldst = (const int*)(F.ws + WS_LDST); S.G = F.G; S.c = F.vcu; \
        S.A = (const char*)(ACT + A_HID); S.B = (const char*)(W + W_D); S.ta = (size_t)256 * 1024; S.eb = (size_t)1024 * 1024; S.tbB = (size_t)256 * 1024; S.gather = false; \
        EpiP8 E{(const int*)(F.ws + WS_LDST), (const float*)(F.ws + WS_LW), (f16*)(ACT + A_C16)}; \
        pg8::gemm_phase<EpiP8, pg8::SchedMoE, false>(ring, 8, 1024u, 1024u, S, E); \
    } \
    SEAM((base) + 8); \
    if (IN((base) + 9)) {              \
        p9_phase(F); \
        { pg8::SchedStd S; S.init(T / 256, 4, F.G, (int)blockIdx.x, F.ws + WS_P16, W + W_PP, (size_t)256 * 512, (size_t)256 * 512); \
          EpiPP E{(f16*)(ACT + A_PP)}; \
          pg8::gemm_phase<EpiPP, pg8::SchedStd, false>(ring, 4, 512u, 512u, S, E); } \
    } \
    SEAM((base) + 9); \
    if (IN((base) + 10)) {             \
        pg8::SchedStd S; S.init(T / 256, 4, F.G, (int)blockIdx.x, H16, W + W_PG, (size_t)256 * 2048, (size_t)256 * 2048); \
        EpiP10 E{(const float*)(F.ws + WS_RS), (const f16*)(ACT + A_PP), (const float*)HB, (layer) == 0 ? HB : F.out, H16, (u64*)(F.ws + WS_CTL + ((layer) == 0 ? CTL_SSQ1 : CTL_SSQ2))}; \
        pg8::gemm_phase<EpiP10, pg8::SchedStd, false>(ring, 16, 2048u, 2048u, S, E); \
    } \
    SEAM((base) + 10); \
    if (IN((base) + 11)) { if ((layer) == 0) prologue(F, 1); else final_phase(F); } \
    } while (0)
    LAYER_BODY(0, 1);
    SEAM(12);
    LAYER_BODY(1, 13);
#undef IN
#undef SEAM
#undef LAYER_BODY
}

extern "C" void kernel_launch(void* const* d_in, const int* in_sizes, int n_in, void* d_out, int out_size, void* d_ws, size_t ws_size, hipStream_t stream) {
    static int grid = 0;
    if (grid == 0) {
        if (n_in != 30 || out_size != T * DM || ws_size < WS_END) { fprintf(stderr, "kernel_launch: unexpected shapes (n_in %d, out %d, ws %zu < %zu)\n", n_in, out_size, ws_size, (size_t)WS_END); grid = -1; return; }
        int dev = 0, cus = 0;
        if (hipGetDevice(&dev) != hipSuccess || hipDeviceGetAttribute(&cus, hipDeviceAttributeMultiprocessorCount, dev) != hipSuccess) { grid = -1; return; }
        if (hipFuncSetAttribute((const void*)mega_fwd, hipFuncAttributeMaxDynamicSharedMemorySize, LDS_BYTES) != hipSuccess) { fprintf(stderr, "kernel_launch: hipFuncSetAttribute failed\n"); grid = -1; return; }
        int per_cu = 0;
        if (hipOccupancyMaxActiveBlocksPerMultiprocessor(&per_cu, (const void*)mega_fwd, NWAVES * 64, LDS_BYTES) != hipSuccess || per_cu < 1) fprintf(stderr, "kernel_launch: occupancy query reports %d\n", per_cu);
        (void)hipGetLastError();
        grid = cus;
    }
    if (grid < 0) return;
    if (hipMemsetAsync((char*)d_ws + WS_CTL, 0, CTL_ZERO_BYTES, stream) != hipSuccess) return;
    Args a{};
    for (int i = 0; i < 30; ++i) a.in[i] = (const float*)d_in[i];
    a.out = (float*)d_out; a.ws = (unsigned char*)d_ws;
#if MK_ONE_LAUNCH
    a.ph_lo = 0; a.ph_hi = N_PHASES;
    hipLaunchKernelGGL(mega_fwd, dim3(grid), dim3(NWAVES * 64), LDS_BYTES, stream, a);
#else
    for (int ph = 0; ph < N_PHASES; ++ph) { a.ph_lo = ph; a.ph_hi = ph + 1; hipLaunchKernelGGL(mega_fwd, dim3(grid), dim3(NWAVES * 64), LDS_BYTES, stream, a); }
#endif
}
```
